# Optimizing an MI355X kernel written in HIP

```python
import jax, jax.numpy as jnp
from jax import lax
import numpy as np

D_MODEL = 2048
BATCH = 2
SEQ = 4096
DEPTH = 1

CHUNK = 64
D_FF = 5632
W_CONV = D_MODEL // 2
CONV_K = 31
W_POOL = D_MODEL // 2
POOL_WINDOWS = (2, 4, 8, 16)
N_POOL_GROUPS = len(POOL_WINDOWS)
POOL_GROUP_IN = W_POOL // N_POOL_GROUPS
POOL_GROUP_OUT = D_MODEL // N_POOL_GROUPS
N_BRANCHES = 2
N_IN_COLS = 2 * W_CONV + W_POOL + N_BRANCHES * D_MODEL
N_ADA = 3
EPS = 1e-6

kernel_name = "hybrid_conformer_pool_gated_block"


def rms_norm(x, g):
    xf = x.astype(jnp.float32)
    y = xf * lax.rsqrt(jnp.mean(xf * xf, axis=-1, keepdims=True) + EPS)
    return y.astype(x.dtype) * g


def layer_norm(x, g, b):
    xf = x.astype(jnp.float32)
    mu = jnp.mean(xf, axis=-1, keepdims=True)
    var = jnp.mean(jnp.square(xf - mu), axis=-1, keepdims=True)
    y = (xf - mu) * lax.rsqrt(var + EPS)
    return y.astype(x.dtype) * g + b


def modulate(n, shift, scale):
    return n * (1.0 + scale[:, None, :]) + shift[:, None, :]


def swiglu(n, w_in, w_out):
    hu = n @ w_in
    h, u = jnp.split(hu, 2, axis=-1)
    return (jax.nn.silu(h) * u) @ w_out


def causal_mean_pool(v, window):
    seq = v.shape[1]
    vf = v.astype(jnp.float32)
    csum = jnp.cumsum(vf, axis=1)
    lagged = jnp.pad(csum, ((0, 0), (window, 0), (0, 0)))[:, :seq]
    count = jnp.minimum(jnp.arange(1, seq + 1, dtype=jnp.float32), float(window))
    return ((csum - lagged) / count[None, :, None]).astype(v.dtype)


def conformer_conv_branch(glu_in, conv_w, conv_b, ln_a_g, ln_a_b, w_a_out, b_a_out):
    a, g = jnp.split(glu_in, 2, axis=-1)
    a = a * jax.nn.sigmoid(g)
    a = lax.conv_general_dilated(
        a, conv_w[:, None, :], window_strides=(1,), padding=[(CONV_K - 1, 0)],
        dimension_numbers=('NWC', 'WIO', 'NWC'), feature_group_count=W_CONV) + conv_b
    a = jax.nn.silu(layer_norm(a, ln_a_g, ln_a_b))
    return a @ w_a_out + b_a_out


def pool_branch(v, w_b_group, b_b_group, ls_b):
    bsz, seq, _ = v.shape
    groups = jnp.split(v, N_POOL_GROUPS, axis=-1)
    mixed = jnp.stack([causal_mean_pool(vg, w) - vg for vg, w in zip(groups, POOL_WINDOWS)], axis=2)
    y = jnp.einsum('bsgc,gco->bsgo', mixed, w_b_group) + b_b_group
    return y.reshape(bsz, seq, D_MODEL) * ls_b


def setup_inputs(seed: int = 0) -> dict:
    key = jax.random.key(seed)
    ks = jax.random.split(key, 32)
    f = jnp.float32
    D = D_MODEL

    def nrm(k, shape, scale):
        return jax.random.normal(k, shape, f) * scale

    def gain(k, shape):
        return 1.0 + 0.05 * jax.random.normal(k, shape, f)

    return {
        'x': nrm(ks[0], (BATCH, SEQ, D), 1.0),
        'c': nrm(ks[1], (BATCH, D), 1.0),
        'w_ada': nrm(ks[2], (D, N_ADA * 3 * D), 0.5 * D ** -0.5),
        'b_ada': nrm(ks[3], (N_ADA * 3 * D,), 0.01),
        'g_ffn1': gain(ks[4], (D,)),
        'w1_in': nrm(ks[5], (D, 2 * D_FF), D ** -0.5),
        'w1_out': nrm(ks[6], (D_FF, D), D_FF ** -0.5),
        'g_mix': gain(ks[7], (D,)),
        'w_in': nrm(ks[8], (D, N_IN_COLS), D ** -0.5),
        'conv_w': nrm(ks[9], (CONV_K, W_CONV), CONV_K ** -0.5),
        'conv_b': nrm(ks[10], (W_CONV,), 0.01),
        'ln_a_g': gain(ks[11], (W_CONV,)),
        'ln_a_b': nrm(ks[12], (W_CONV,), 0.01),
        'w_a_out': nrm(ks[13], (W_CONV, D), W_CONV ** -0.5),
        'b_a_out': nrm(ks[14], (D,), 0.01),
        'w_b_group': nrm(ks[15], (N_POOL_GROUPS, POOL_GROUP_IN, POOL_GROUP_OUT), POOL_GROUP_IN ** -0.5),
        'b_b_group': nrm(ks[16], (N_POOL_GROUPS, POOL_GROUP_OUT), 0.01),
        'ls_b': gain(ks[17], (D,)),
        'w_out': nrm(ks[18], (D, D), D ** -0.5),
        'g_ffn2': gain(ks[19], (D,)),
        'w2_in': nrm(ks[20], (D, 2 * D_FF), D ** -0.5),
        'w2_out': nrm(ks[21], (D_FF, D), D_FF ** -0.5),
        'g_final': gain(ks[22], (D,)),
    }


def reference(x, c, w_ada, b_ada, g_ffn1, w1_in, w1_out, g_mix, w_in, conv_w, conv_b,
              ln_a_g, ln_a_b, w_a_out, b_a_out, w_b_group, b_b_group, ls_b, w_out,
              g_ffn2, w2_in, w2_out, g_final):
    bsz = x.shape[0]
    ada = (jax.nn.silu(c) @ w_ada + b_ada).reshape(bsz, N_ADA, 3, D_MODEL)
    h = x
    for _ in range(DEPTH):
        n = modulate(rms_norm(h, g_ffn1), ada[:, 0, 0], ada[:, 0, 1])
        h = h + 0.5 * ada[:, 0, 2][:, None, :] * swiglu(n, w1_in, w1_out)

        n = modulate(rms_norm(h, g_mix), ada[:, 1, 0], ada[:, 1, 1])
        proj = n @ w_in
        glu_in = proj[..., :2 * W_CONV]
        pool_in = proj[..., 2 * W_CONV:2 * W_CONV + W_POOL]
        gate_a = jax.nn.sigmoid(proj[..., 2 * W_CONV + W_POOL:2 * W_CONV + W_POOL + D_MODEL])
        gate_b = jax.nn.sigmoid(proj[..., 2 * W_CONV + W_POOL + D_MODEL:])
        y_a = conformer_conv_branch(glu_in, conv_w, conv_b, ln_a_g, ln_a_b, w_a_out, b_a_out)
        y_b = pool_branch(pool_in, w_b_group, b_b_group, ls_b)
        mix = (gate_a * y_a + gate_b * y_b) @ w_out
        h = h + ada[:, 1, 2][:, None, :] * mix

        n = modulate(rms_norm(h, g_ffn2), ada[:, 2, 0], ada[:, 2, 1])
        h = h + 0.5 * ada[:, 2, 2][:, None, :] * swiglu(n, w2_in, w2_out)
    return rms_norm(h, g_final)
```

```cpp
#include <hip/hip_runtime.h>
#include <hip/hip_cooperative_groups.h>
#include <cstdio>
#include <cstdint>
namespace cg = cooperative_groups;

#define LAS __attribute__((address_space(3)))
typedef unsigned short bf16_t;
typedef short bf16x8 __attribute__((ext_vector_type(8)));
typedef float f32x4 __attribute__((ext_vector_type(4)));
typedef float f32x2 __attribute__((ext_vector_type(2)));
typedef unsigned u32x4 __attribute__((ext_vector_type(4)));
typedef unsigned u32x2 __attribute__((ext_vector_type(2)));

#ifndef MK_N_LAUNCHES
#define MK_N_LAUNCHES 1
#endif

constexpr int BATCH = 2, SEQ = 4096, D = 2048, M = BATCH * SEQ, FF = 5632, WC = 1024, WP = 1024, NIN = 7168, NADA = 18432, CONVK = 31;
constexpr float EPS = 1e-6f;
constexpr int NPH = 13;
constexpr int ADA_KC = 8, ADA_CC = NADA / 256, ADA_ITEMS = ADA_KC * ADA_CC;

constexpr size_t MiB = 1u << 20;
constexpr size_t WS_PART = 0, WS_ADA = 2 * MiB;
constexpr size_t WS_W1IN = 4 * MiB, WS_W1OUT = 48 * MiB, WS_WIN = 70 * MiB, WS_WAOUT = 98 * MiB, WS_WB = 102 * MiB, WS_WOUT = 103 * MiB, WS_W2IN = 111 * MiB, WS_W2OUT = 155 * MiB;
constexpr size_t WS_XN = 178 * MiB, WS_ACT = 210 * MiB, WS_GLU = 298 * MiB, WS_POOLIN = 314 * MiB, WS_GATEA = 330 * MiB, WS_GATEB = 362 * MiB;
constexpr size_t WS_AACT = 394 * MiB, WS_MIXED = 410 * MiB, WS_MIXM = 426 * MiB, WS_TMP = 458 * MiB, WS_END = 490 * MiB;

constexpr int LDS_BYTES = 147456;

__device__ __forceinline__ unsigned cvt_pk_bf16(float lo, float hi) { unsigned r; asm volatile("v_cvt_pk_bf16_f32 %0, %1, %2" : "=v"(r) : "v"(lo), "v"(hi)); return r; }
__device__ __forceinline__ float bf_lo(unsigned u) { return __uint_as_float(u << 16); }
__device__ __forceinline__ float bf_hi(unsigned u) { return __uint_as_float(u & 0xffff0000u); }
__device__ __forceinline__ float sigm(float x) { return __builtin_amdgcn_rcpf(1.0f + __expf(-x)); }
__device__ __forceinline__ float wave_sum(float v) {
#pragma unroll
    for (int o = 1; o < 64; o <<= 1) v += __shfl_xor(v, o);
    return v;
}

namespace pg8 {
constexpr int BM = 256, BK = 64, HALF = 128, HTB = HALF * BK * 2, STAGE_BYTES = 8 * HTB, NXCD = 8, WGM = 8;

__host__ __device__ __forceinline__ int lds_byte(int r, int c) { const int st = (r >> 4) * 2 + (c >> 5), rr = r & 15, cc = c & 31, ob = rr * 64 + cc * 2; return st * 1024 + (ob ^ (((ob >> 9) & 1) << 5)); }
__host__ __device__ __forceinline__ void stage_rc(int b, int& R, int& C) { const int st = b / 1024, sb = b % 1024, swz = sb ^ (((sb >> 9) & 1) << 5); R = (st >> 1) * 16 + swz / 64; C = (st & 1) * 32 + (swz % 64) / 2; }
__host__ __device__ __forceinline__ int perm32(int rho) { const int n = rho >> 4, i = rho & 15; return 8 * (i >> 2) + 4 * n + (i & 3); }

struct Unit { int pm, pn; };
struct Gemm { const bf16_t* A; const bf16_t* Bt; int M, N, K, lda, ldb, agshift, agbytes; };

struct StaticOrder {
    int nM, nN, nwg, G, c;
    __host__ __device__ void init(int M_, int N_, int G_, int c_) { nM = M_ / BM; nN = N_ / BM; nwg = nM * nN; G = G_; c = c_; }
    __host__ __device__ bool next(int i, Unit& u) const {
        const long L = (long)i * G + c; if (L >= nwg) return false;
        int wgid = (int)L; { const int q = nwg / NXCD, r = nwg % NXCD, xcd = wgid % NXCD, off = wgid / NXCD; wgid = (xcd < r ? xcd * (q + 1) : r * (q + 1) + (xcd - r) * q) + off; }
        const int nig = WGM * nN, gid = wgid / nig, fm = gid * WGM, gsz = (nM - fm) < WGM ? (nM - fm) : WGM;
        u.pm = fm + ((wgid % nig) % gsz); u.pn = (wgid % nig) / gsz; return true;
    }
};


template <int MODE>
__device__ __forceinline__ void pair_store(const f32x4 (&acc)[2][2][4][2], const Unit& u, int wr, int wc, int fr, int fq, bf16_t* O, int ldc, int ct) {
    const int row0 = u.pm * BM + wr * 64 + fr, col0 = ct * 128 + wc * 32 + 8 * fq;
#pragma unroll
    for (int ai = 0; ai < 2; ++ai)
#pragma unroll
        for (int m = 0; m < 4; ++m) {
            bf16_t* rowp = O + (size_t)(row0 + ai * HALF + m * 16) * ldc + col0;
            float o[8];
#pragma unroll
            for (int n = 0; n < 2; ++n)
#pragma unroll
                for (int e = 0; e < 4; ++e) { const float p = acc[ai][0][m][n][e], q = acc[ai][1][m][n][e]; o[n * 4 + e] = (MODE == 0) ? p * sigm(p) * q : p * sigm(q); }
            u32x4 w; w.x = cvt_pk_bf16(o[0], o[1]); w.y = cvt_pk_bf16(o[2], o[3]); w.z = cvt_pk_bf16(o[4], o[5]); w.w = cvt_pk_bf16(o[6], o[7]);
            *(u32x4*)rowp = w;
        }
}
template <int ACT>
__device__ __forceinline__ void tile_store(const f32x4 (&acc)[2][2][4][2], const Unit& u, int wr, int wc, int fr, int fq, bf16_t* O, int ldc, int colt) {
    const int row0 = u.pm * BM + wr * 64 + fr, col0 = colt + wc * 32 + 8 * fq;
#pragma unroll
    for (int ai = 0; ai < 2; ++ai)
#pragma unroll
        for (int m = 0; m < 4; ++m) {
            bf16_t* rowp = O + (size_t)(row0 + ai * HALF + m * 16) * ldc + col0;
#pragma unroll
            for (int bj = 0; bj < 2; ++bj) {
                f32x4 v0 = acc[ai][bj][m][0], v1 = acc[ai][bj][m][1];
                if (ACT == 1) {
#pragma unroll
                    for (int e = 0; e < 4; ++e) { v0[e] = sigm(v0[e]); v1[e] = sigm(v1[e]); }
                }
                u32x4 w; w.x = cvt_pk_bf16(v0[0], v0[1]); w.y = cvt_pk_bf16(v0[2], v0[3]); w.z = cvt_pk_bf16(v1[0], v1[1]); w.w = cvt_pk_bf16(v1[2], v1[3]);
                *(u32x4*)(rowp + bj * HALF) = w;
            }
        }
}

struct EpiSwiGLU {
    static constexpr bool PERM = true;
    bf16_t* O;
    __device__ __forceinline__ void operator()(const f32x4 (&acc)[2][2][4][2], const Unit& u, int wr, int wc, int fr, int fq) const { pair_store<0>(acc, u, wr, wc, fr, fq, O, FF, u.pn); }
};
struct EpiMixIn {
    static constexpr bool PERM = true;
    bf16_t *glu, *poolin, *gatea, *gateb;
    __device__ __forceinline__ void operator()(const f32x4 (&acc)[2][2][4][2], const Unit& u, int wr, int wc, int fr, int fq) const {
        if (u.pn < 8) pair_store<1>(acc, u, wr, wc, fr, fq, glu, WC, u.pn);
        else if (u.pn < 12) tile_store<0>(acc, u, wr, wc, fr, fq, poolin, WP, (u.pn - 8) * BM);
        else if (u.pn < 20) tile_store<0>(acc, u, wr, wc, fr, fq, gatea, D, (u.pn - 12) * BM);
        else tile_store<0>(acc, u, wr, wc, fr, fq, gateb, D, (u.pn - 20) * BM);
    }
};
struct EpiResid {
    static constexpr bool PERM = false;
    const float* base; float* out; const float* gate; float s;
    __device__ __forceinline__ void operator()(const f32x4 (&acc)[2][2][4][2], const Unit& u, int wr, int wc, int fr, int fq) const {
        const int b = u.pm >> 4, col0 = u.pn * BM + wc * 32 + 4 * fq;
        const float* gp = gate + (size_t)b * NADA + col0;
        f32x4 gv[2][2];
#pragma unroll
        for (int bj = 0; bj < 2; ++bj)
#pragma unroll
            for (int n = 0; n < 2; ++n) gv[bj][n] = *(const f32x4*)(gp + bj * HALF + n * 16) * s;
#pragma unroll
        for (int ai = 0; ai < 2; ++ai)
#pragma unroll
            for (int m = 0; m < 4; ++m) {
                const size_t off = (size_t)(u.pm * BM + ai * HALF + wr * 64 + m * 16 + fr) * D + col0;
#pragma unroll
                for (int bj = 0; bj < 2; ++bj)
#pragma unroll
                    for (int n = 0; n < 2; ++n) { const f32x4 bs = *(const f32x4*)(base + off + bj * HALF + n * 16); *(f32x4*)(out + off + bj * HALF + n * 16) = bs + gv[bj][n] * acc[ai][bj][m][n]; }
                if (m & 1) asm volatile("" ::: "memory");
            }
    }
};
template <bool FIRST>
struct EpiMixOut {
    static constexpr bool PERM = true;
    const bf16_t* gatev; const float* bias; const float* ls; const bf16_t* tmp_in; bf16_t* O;
    __device__ __forceinline__ void operator()(const f32x4 (&acc)[2][2][4][2], const Unit& u, int wr, int wc, int fr, int fq) const {
        const int row0 = u.pm * BM + wr * 64 + fr, col0 = u.pn * BM + wc * 32 + 8 * fq;
#pragma unroll
        for (int ai = 0; ai < 2; ++ai)
#pragma unroll
            for (int m = 0; m < 4; ++m) {
                const size_t off = (size_t)(row0 + ai * HALF + m * 16) * D + col0;
#pragma unroll
                for (int bj = 0; bj < 2; ++bj) {
                    const u32x4 gw = *(const u32x4*)(gatev + off + bj * HALF);
                    const f32x4 b0 = *(const f32x4*)(bias + col0 + bj * HALF), b1 = *(const f32x4*)(bias + col0 + bj * HALF + 4);
                    f32x4 v0 = acc[ai][bj][m][0] + b0, v1 = acc[ai][bj][m][1] + b1;
                    const f32x4 g0 = (f32x4){sigm(bf_lo(gw.x)), sigm(bf_hi(gw.x)), sigm(bf_lo(gw.y)), sigm(bf_hi(gw.y))}, g1 = (f32x4){sigm(bf_lo(gw.z)), sigm(bf_hi(gw.z)), sigm(bf_lo(gw.w)), sigm(bf_hi(gw.w))};
                    if (FIRST) { const f32x4 l0 = *(const f32x4*)(ls + col0 + bj * HALF), l1 = *(const f32x4*)(ls + col0 + bj * HALF + 4); v0 = v0 * l0 * g0; v1 = v1 * l1 * g1; }
                    else {
                        const u32x4 tw = *(const u32x4*)(tmp_in + off + bj * HALF);
                        v0 = v0 * g0 + (f32x4){bf_lo(tw.x), bf_hi(tw.x), bf_lo(tw.y), bf_hi(tw.y)};
                        v1 = v1 * g1 + (f32x4){bf_lo(tw.z), bf_hi(tw.z), bf_lo(tw.w), bf_hi(tw.w)};
                    }
                    u32x4 w; w.x = cvt_pk_bf16(v0[0], v0[1]); w.y = cvt_pk_bf16(v0[2], v0[3]); w.z = cvt_pk_bf16(v1[0], v1[1]); w.w = cvt_pk_bf16(v1[2], v1[3]);
                    *(u32x4*)(O + off + bj * HALF) = w;
                }
                asm volatile("" ::: "memory");
            }
    }
};

template <class Epi>
__device__ __forceinline__ void gemm_phase(LAS unsigned char* lds, const Gemm g, const StaticOrder& S, const Epi& E) {
    const int tid = threadIdx.x, wid = __builtin_amdgcn_readfirstlane(tid >> 6), lane = tid & 63, wr = wid >> 2, wc = wid & 3, fr = lane & 15, fq = lane >> 4;
    const int K = g.K, nt = K / BK;
    unsigned voffA[2], voffB[2];
#pragma unroll
    for (int i = 0; i < 2; ++i) { int R, C; stage_rc(tid * 16 + i * 8192, R, C); const int Rb = Epi::PERM ? ((R & ~31) + perm32(R & 31)) : R;
        voffA[i] = (unsigned)(R * g.lda + C) * 2u; voffB[i] = (unsigned)(Rb * g.ldb + C) * 2u; }
    const size_t kstep = (size_t)(BK * 2);
    const size_t hstepA = (size_t)HALF * g.lda * 2, hstepB = (size_t)HALF * g.ldb * 2;
    const size_t tstepA = 2 * hstepA, tstepB = 2 * hstepB;
    const unsigned ldsw = (unsigned)wid * 1024u;
    const int aoff = lds_byte(wr * 64 + fr, fq * 8), boff = lds_byte(wc * 32 + fr, fq * 8);
#define PG8_SA(b, h) (((b) * 2 + (h)) * HTB)
#define PG8_SB(b, h) ((4 + (b) * 2 + (h)) * HTB)
#define PG8_STAGE(bufoff, gbase, voff) do { _Pragma("unroll") for (int _i = 0; _i < 2; ++_i) \
        __builtin_amdgcn_global_load_lds((const unsigned*)((const char*)(gbase) + (voff)[_i]), (LAS unsigned*)(lds + (bufoff) + ldsw + _i * 8192), 16, 0, 0); } while (0)
#define PG8_LDA(dst, b, h) do { _Pragma("unroll") for (int m = 0; m < 4; ++m) _Pragma("unroll") for (int k = 0; k < 2; ++k) dst[m][k] = *(const LAS bf16x8*)(lds + PG8_SA(b, h) + aoff + m * 2048 + k * 1024); } while (0)
#define PG8_LDB(dst, b, h) do { _Pragma("unroll") for (int n = 0; n < 2; ++n) _Pragma("unroll") for (int k = 0; k < 2; ++k) dst[n][k] = *(const LAS bf16x8*)(lds + PG8_SB(b, h) + boff + n * 2048 + k * 1024); } while (0)
#define PG8_MMA(ai, bj, At, Bt) do { __builtin_amdgcn_s_setprio(1); _Pragma("unroll") for (int m = 0; m < 4; ++m) _Pragma("unroll") for (int n = 0; n < 2; ++n) _Pragma("unroll") for (int k = 0; k < 2; ++k) \
        acc[ai][bj][m][n] = __builtin_amdgcn_mfma_f32_16x16x32_bf16(Bt[n][k], At[m][k], acc[ai][bj][m][n], 0, 0, 0); __builtin_amdgcn_s_setprio(0); } while (0)
#define PG8_WAIT_V(n) asm volatile("s_waitcnt vmcnt(" #n ")" ::: "memory")
#define PG8_WAIT_L(n) asm volatile("s_waitcnt lgkmcnt(" #n ")" ::: "memory")
#define PG8_BAR __builtin_amdgcn_s_barrier()
#define PG8_SCHED __builtin_amdgcn_sched_barrier(0)
    Unit cur, nxt; int ui = 0;
    if (!S.next(0, cur)) return;
    f32x4 acc[2][2][4][2];
#pragma unroll
    for (int a = 0; a < 2; ++a)
#pragma unroll
        for (int b = 0; b < 2; ++b)
#pragma unroll
            for (int m = 0; m < 4; ++m)
#pragma unroll
                for (int n = 0; n < 2; ++n) acc[a][b][m][n] = (f32x4){0.f, 0.f, 0.f, 0.f};
    bf16x8 At[4][2], B0[2][2], B1[2][2];
    const char* cA = (const char*)g.A + (size_t)cur.pm * tstepA + (size_t)(cur.pn >> g.agshift) * g.agbytes; const char* cB = (const char*)g.Bt + (size_t)cur.pn * tstepB;
    PG8_STAGE(PG8_SB(0, 0), cB, voffB); PG8_STAGE(PG8_SB(0, 1), cB + hstepB, voffB); PG8_STAGE(PG8_SA(0, 0), cA, voffA); PG8_STAGE(PG8_SA(0, 1), cA + hstepA, voffA);
    if (wr == 1) PG8_BAR;
    PG8_WAIT_V(2); PG8_BAR;
    PG8_STAGE(PG8_SB(1, 0), cB + kstep, voffB); PG8_STAGE(PG8_SA(1, 0), cA + kstep, voffA); PG8_STAGE(PG8_SB(1, 1), cB + hstepB + kstep, voffB);
    PG8_WAIT_V(6); PG8_BAR;
    for (;;) {
        const bool has_next = S.next(ui + 1, nxt);
        const char* nA = has_next ? (const char*)g.A + (size_t)nxt.pm * tstepA + (size_t)(nxt.pn >> g.agshift) * g.agbytes : cA; const char* nB = has_next ? (const char*)g.Bt + (size_t)nxt.pn * tstepB : cB;
#pragma unroll 1
        for (int t = 0; t < nt; t += 2) {
            const bool last = (t == nt - 2);
            const char* a1 = cA + (size_t)(t + 1) * kstep;
            const char* a2 = last ? nA : cA + (size_t)(t + 2) * kstep; const char* b2 = last ? nB : cB + (size_t)(t + 2) * kstep;
            const char* a3 = a2 + kstep; const char* b3 = b2 + kstep;
            PG8_LDB(B0, 0, 0); PG8_LDB(B1, 0, 1); PG8_SCHED; PG8_LDA(At, 0, 0); PG8_STAGE(PG8_SA(1, 1), a1 + hstepA, voffA);
            PG8_WAIT_V(8); PG8_WAIT_L(0); PG8_BAR; PG8_MMA(0, 0, At, B0); PG8_MMA(0, 1, At, B1); PG8_BAR; PG8_SCHED;
            PG8_LDA(At, 0, 1); PG8_STAGE(PG8_SB(0, 0), b2, voffB); PG8_STAGE(PG8_SB(0, 1), b2 + hstepB, voffB); PG8_STAGE(PG8_SA(0, 0), a2, voffA);
            PG8_WAIT_V(8); PG8_WAIT_L(0); PG8_BAR; PG8_MMA(1, 0, At, B0); PG8_MMA(1, 1, At, B1); PG8_BAR; PG8_SCHED;
            PG8_LDB(B0, 1, 0); PG8_LDB(B1, 1, 1); PG8_SCHED; PG8_LDA(At, 1, 0); PG8_STAGE(PG8_SA(0, 1), a2 + hstepA, voffA);
            PG8_WAIT_V(8); PG8_WAIT_L(0); PG8_BAR; PG8_MMA(0, 0, At, B0); PG8_MMA(0, 1, At, B1); PG8_BAR; PG8_SCHED;
            PG8_LDA(At, 1, 1); PG8_STAGE(PG8_SB(1, 0), b3, voffB); PG8_STAGE(PG8_SB(1, 1), b3 + hstepB, voffB); PG8_STAGE(PG8_SA(1, 0), a3, voffA);
            PG8_WAIT_V(8); PG8_WAIT_L(0); PG8_BAR; PG8_MMA(1, 0, At, B0); PG8_MMA(1, 1, At, B1); PG8_BAR; PG8_SCHED;
        }
        if (wr == 0) PG8_BAR;
        asm volatile("" ::: "memory");
        E(acc, cur, wr, wc, fr, fq);
        asm volatile("" ::: "memory");
        if (!has_next) break;
#pragma unroll
        for (int a = 0; a < 2; ++a)
#pragma unroll
            for (int b = 0; b < 2; ++b)
#pragma unroll
                for (int m = 0; m < 4; ++m)
#pragma unroll
                    for (int n = 0; n < 2; ++n) acc[a][b][m][n] = (f32x4){0.f, 0.f, 0.f, 0.f};
        cur = nxt; cA = nA; cB = nB; ++ui;
        if (wr == 1) PG8_BAR;
    }
    PG8_WAIT_V(0);
    PG8_BAR;
#undef PG8_SA
#undef PG8_SB
#undef PG8_STAGE
#undef PG8_LDA
#undef PG8_LDB
#undef PG8_MMA
#undef PG8_WAIT_V
#undef PG8_WAIT_L
#undef PG8_BAR
#undef PG8_SCHED
}
}

__device__ __forceinline__ void tr_tile(const float* __restrict__ W, int N, int k0, int n0, bf16_t* __restrict__ WT, int ldk, int drow0, LAS unsigned* scr, int lane) {
    const int l16 = lane & 15, lq = lane >> 4;
    f32x4 v[16];
#pragma unroll
    for (int i = 0; i < 16; ++i) { const int kk = 8 * (i >> 1) + 2 * lq + (i & 1); v[i] = __builtin_nontemporal_load((const f32x4*)(W + (size_t)(k0 + kk) * N + n0 + 4 * l16)); }
#pragma unroll
    for (int p = 0; p < 8; ++p) {
        const f32x4 a = v[2 * p], b = v[2 * p + 1];
        const int chunk = (p ^ (l16 & 7)) * 4 + lq;
#pragma unroll
        for (int j = 0; j < 4; ++j) scr[(4 * l16 + j) * 32 + chunk] = cvt_pk_bf16(a[j], b[j]);
    }
    asm volatile("s_waitcnt lgkmcnt(0)" ::: "memory");
#pragma unroll
    for (int jj = 0; jj < 8; ++jj) {
        const int n = (lane >> 3) + 8 * jj, c = lane & 7;
        const u32x4 o = *(const LAS u32x4*)(scr + n * 32 + ((c ^ ((n >> 2) & 7)) * 4));
        *(u32x4*)(WT + (size_t)(drow0 + n) * ldk + k0 + 8 * c) = o;
    }
    asm volatile("s_waitcnt lgkmcnt(0)" ::: "memory");
}
__device__ __forceinline__ void tr_item(const float* W, int K, int N, bf16_t* WT, int ph, int r, LAS unsigned* scr, int lane) {
    const int nblk = N >> 6, kb = r / nblk, nb = r - kb * nblk, n0 = nb << 6;
    int drow0 = n0;
    if (n0 < 2 * ph) { const int second = n0 >= ph, j = n0 - (second ? ph : 0); drow0 = 256 * (j >> 7) + 128 * second + (j & 127); }
    tr_tile(W, N, kb << 6, n0, WT, K, drow0, scr, lane);
}
__device__ __forceinline__ void ada_item(const float* __restrict__ c, const float* __restrict__ w_ada, float* __restrict__ part, int item, int lane) {
    const int kc = item / ADA_CC, cc = item - kc * ADA_CC, k0 = kc * 256, col = cc * 256 + 4 * lane;
    float s0[4], s1[4];
#pragma unroll
    for (int q = 0; q < 4; ++q) { const float a = c[k0 + 64 * q + lane], b = c[D + k0 + 64 * q + lane]; s0[q] = a * sigm(a); s1[q] = b * sigm(b); }
    f32x4 acc0 = {0.f, 0.f, 0.f, 0.f}, acc1 = {0.f, 0.f, 0.f, 0.f};
    const float* wp = w_ada + (size_t)k0 * NADA + col;
#pragma unroll
    for (int q = 0; q < 4; ++q) {
        for (int l0 = 0; l0 < 64; l0 += 16) {
            f32x4 w[16];
#pragma unroll
            for (int i = 0; i < 16; ++i) w[i] = __builtin_nontemporal_load((const f32x4*)(wp + (size_t)(64 * q + l0 + i) * NADA));
#pragma unroll
            for (int i = 0; i < 16; ++i) {
                const float a = __uint_as_float(__builtin_amdgcn_readlane(__float_as_uint(s0[q]), l0 + i)), b = __uint_as_float(__builtin_amdgcn_readlane(__float_as_uint(s1[q]), l0 + i));
                acc0 += w[i] * a; acc1 += w[i] * b;
            }
        }
    }
    *(f32x4*)(part + (size_t)(kc * 2 + 0) * NADA + col) = acc0;
    *(f32x4*)(part + (size_t)(kc * 2 + 1) * NADA + col) = acc1;
}

struct Args { const float* in[23]; float* out; unsigned char* ws; int ph_lo, ph_hi, dump_sel, pad; };
typedef const __attribute__((address_space(4))) Args* KArgs;
__device__ __forceinline__ KArgs kargs() { KArgs p = (KArgs)__builtin_amdgcn_kernarg_segment_ptr(); asm volatile("" : "+s"(p)); return p; }

__device__ __forceinline__ void prologue_phase(LAS unsigned char* lds, int wave, int lane) {
    const KArgs ka = kargs();
    const int gw = blockIdx.x * 8 + wave, NGW = gridDim.x * 8;
    unsigned char* ws = ka->ws;
    LAS unsigned* scr = (LAS unsigned*)(lds + wave * 16384);
    constexpr int T_1IN = (D / 64) * (2 * FF / 64), T_1OUT = (FF / 64) * (D / 64), T_IN = (D / 64) * (NIN / 64), T_AOUT = (WC / 64) * (D / 64), T_B = (256 / 64) * (512 / 64), T_OUT = (D / 64) * (D / 64);
    constexpr int NT = 2 * T_1IN + 2 * T_1OUT + T_IN + T_AOUT + 4 * T_B + T_OUT;
    int first, stride;
    if (NGW > ADA_ITEMS) {
        if (gw < ADA_ITEMS) { ada_item(ka->in[1], ka->in[2], (float*)(ws + WS_PART), gw, lane); return; }
        first = gw - ADA_ITEMS; stride = NGW - ADA_ITEMS;
    } else {
        for (int it = gw; it < ADA_ITEMS; it += NGW) ada_item(ka->in[1], ka->in[2], (float*)(ws + WS_PART), it, lane);
        first = gw; stride = NGW;
    }
    for (int it = first; it < NT; it += stride) {
        int r = it;
        if (r < T_1IN) { tr_item(ka->in[5], D, 2 * FF, (bf16_t*)(ws + WS_W1IN), FF, r, scr, lane); continue; } r -= T_1IN;
        if (r < T_1OUT) { tr_item(ka->in[6], FF, D, (bf16_t*)(ws + WS_W1OUT), 0, r, scr, lane); continue; } r -= T_1OUT;
        if (r < T_IN) { tr_item(ka->in[8], D, NIN, (bf16_t*)(ws + WS_WIN), WC, r, scr, lane); continue; } r -= T_IN;
        if (r < T_AOUT) { tr_item(ka->in[13], WC, D, (bf16_t*)(ws + WS_WAOUT), 0, r, scr, lane); continue; } r -= T_AOUT;
        if (r < 4 * T_B) { const int grp = r / T_B; tr_item(ka->in[15] + (size_t)grp * 256 * 512, 256, 512, (bf16_t*)(ws + WS_WB) + (size_t)grp * 512 * 256, 0, r - grp * T_B, scr, lane); continue; } r -= 4 * T_B;
        if (r < T_OUT) { tr_item(ka->in[18], D, D, (bf16_t*)(ws + WS_WOUT), 0, r, scr, lane); continue; } r -= T_OUT;
        if (r < T_1IN) { tr_item(ka->in[20], D, 2 * FF, (bf16_t*)(ws + WS_W2IN), FF, r, scr, lane); continue; } r -= T_1IN;
        tr_item(ka->in[21], FF, D, (bf16_t*)(ws + WS_W2OUT), 0, r, scr, lane);
    }
}

__device__ __forceinline__ void norm_phase(LAS float* ldsf, const float* __restrict__ src, bf16_t* __restrict__ XN, const float* __restrict__ g, float* ada, int sub, const float* __restrict__ part, const float* __restrict__ b_ada, int tid, int wave, int lane) {
    if (part) {
        for (int idx = blockIdx.x * 512 + tid; idx < BATCH * NADA; idx += gridDim.x * 512) {
            const int b = idx / NADA, j = idx - b * NADA; float s = b_ada[j];
#pragma unroll
            for (int p = 0; p < ADA_KC; ++p) s += part[(size_t)(p * 2 + b) * NADA + j];
            ada[idx] = s;
        }
    }
    for (int rb = blockIdx.x; rb < M / 32; rb += gridDim.x) {
        const int b = rb / (SEQ / 32);
        for (int c = tid; c < D; c += 512) {
            const int jsh = sub * 6144 + c, jsc = jsh + D; float sh, sc;
            if (part) { sh = b_ada[jsh]; sc = b_ada[jsc];
#pragma unroll
                for (int p = 0; p < ADA_KC; ++p) { sh += part[(size_t)(p * 2 + b) * NADA + jsh]; sc += part[(size_t)(p * 2 + b) * NADA + jsc]; } }
            else { sh = ada[(size_t)b * NADA + jsh]; sc = ada[(size_t)b * NADA + jsc]; }
            ldsf[c] = g[c] * (1.0f + sc); ldsf[D + c] = sh;
        }
        __syncthreads();
#pragma unroll 1
        for (int i = 0; i < 4; ++i) {
            const int row = rb * 32 + wave * 4 + i;
            const f32x4* xr = (const f32x4*)(src + (size_t)row * D) + lane;
            f32x4 v[8]; float ss = 0.f;
#pragma unroll
            for (int j = 0; j < 8; ++j) { v[j] = xr[64 * j]; ss += (v[j].x * v[j].x + v[j].y * v[j].y) + (v[j].z * v[j].z + v[j].w * v[j].w); }
            const float rstd = rsqrtf(wave_sum(ss) * (1.0f / D) + EPS);
            u32x2* o8 = (u32x2*)(XN + (size_t)row * D) + lane;
#pragma unroll
            for (int j = 0; j < 8; ++j) {
                const f32x4 av = *(const LAS f32x4*)(ldsf + 4 * lane + 256 * j), sv = *(const LAS f32x4*)(ldsf + D + 4 * lane + 256 * j);
                const f32x4 o = v[j] * rstd * av + sv;
                u32x2 w; w.x = cvt_pk_bf16(o.x, o.y); w.y = cvt_pk_bf16(o.z, o.w); o8[64 * j] = w;
            }
        }
        __syncthreads();
    }
}
__device__ __forceinline__ void final_norm_phase(float* io, const float* __restrict__ g, int wave, int lane) {
    for (int row = blockIdx.x * 8 + wave; row < M; row += gridDim.x * 8) {
        f32x4* xr = (f32x4*)(io + (size_t)row * D) + lane;
        f32x4 v[8]; float ss = 0.f;
#pragma unroll
        for (int j = 0; j < 8; ++j) { v[j] = xr[64 * j]; ss += (v[j].x * v[j].x + v[j].y * v[j].y) + (v[j].z * v[j].z + v[j].w * v[j].w); }
        const float rstd = rsqrtf(wave_sum(ss) * (1.0f / D) + EPS);
#pragma unroll
        for (int j = 0; j < 8; ++j) { const f32x4 gv = *((const f32x4*)g + lane + 64 * j); xr[64 * j] = v[j] * rstd * gv; }
    }
}

__device__ __forceinline__ void convpool_phase(LAS float* ldsf, const bf16_t* __restrict__ GLU, const bf16_t* __restrict__ POOLIN, const float* __restrict__ conv_w, const float* __restrict__ conv_b,
                                               const float* __restrict__ ln_g, const float* __restrict__ ln_b, bf16_t* __restrict__ AACT, bf16_t* __restrict__ MIXED, int tid, int wave, int lane) {
    const int c0 = 2 * tid;
    LAS float* red = ldsf;
    LAS float* stat = ldsf + 256;
    for (int ch = blockIdx.x; ch < M / 16; ch += gridDim.x) {
        const int t0 = ch * 16, tb = t0 & ~(SEQ - 1);
        {
            float w0[CONVK], w1[CONVK];
#pragma unroll
            for (int j = 0; j < CONVK; ++j) { const f32x2 w = *(const f32x2*)(conv_w + j * WC + c0); w0[j] = w.x; w1[j] = w.y; }
            unsigned rows[46];
#pragma unroll
            for (int r = 0; r < 46; ++r) { const int t = t0 - 30 + r; rows[r] = (t >= tb) ? *(const unsigned*)(GLU + (size_t)t * WC + c0) : 0u; }
            const f32x2 cb = *(const f32x2*)(conv_b + c0);
            float o0[16], o1[16];
#pragma unroll
            for (int i = 0; i < 16; ++i) {
                float a0 = cb.x, a1 = cb.y;
#pragma unroll
                for (int j = 0; j < CONVK; ++j) { a0 += bf_lo(rows[i + j]) * w0[j]; a1 += bf_hi(rows[i + j]) * w1[j]; }
                o0[i] = a0; o1[i] = a1;
                const float s = wave_sum(a0 + a1), q = wave_sum(a0 * a0 + a1 * a1);
                if (lane == 0) { red[(i * 8 + wave) * 2] = s; red[(i * 8 + wave) * 2 + 1] = q; }
            }
            __syncthreads();
            if (tid < 16) {
                float s = 0.f, q = 0.f;
#pragma unroll
                for (int w = 0; w < 8; ++w) { s += red[(tid * 8 + w) * 2]; q += red[(tid * 8 + w) * 2 + 1]; }
                const float mean = s * (1.0f / WC), var = fmaxf(q * (1.0f / WC) - mean * mean, 0.f);
                stat[tid * 2] = mean; stat[tid * 2 + 1] = rsqrtf(var + EPS);
            }
            __syncthreads();
            const f32x2 lg = *(const f32x2*)(ln_g + c0), lb = *(const f32x2*)(ln_b + c0);
#pragma unroll
            for (int i = 0; i < 16; ++i) {
                const float mean = stat[i * 2], rstd = stat[i * 2 + 1];
                float y0 = (o0[i] - mean) * rstd * lg.x + lb.x, y1 = (o1[i] - mean) * rstd * lg.y + lb.y;
                y0 = y0 * sigm(y0); y1 = y1 * sigm(y1);
                *(unsigned*)(AACT + (size_t)(t0 + i) * WC + c0) = cvt_pk_bf16(y0, y1);
            }
        }
        {
            const int grp = c0 >> 8; const float wf = (float)(2 << grp);
            unsigned rows[31];
#pragma unroll
            for (int r = 0; r < 31; ++r) { const int t = t0 - 15 + r; rows[r] = (t >= tb) ? *(const unsigned*)(POOLIN + (size_t)t * WP + c0) : 0u; }
#pragma unroll
            for (int i = 0; i < 16; ++i) {
                const int r = 15 + i;
                float a0 = 0.f, a1 = 0.f, s0 = 0.f, s1 = 0.f;
#pragma unroll
                for (int d = 0; d < 16; ++d) {
                    a0 += bf_lo(rows[r - d]); a1 += bf_hi(rows[r - d]);
                    if (d == 1) { if (grp == 0) { s0 = a0; s1 = a1; } }
                    if (d == 3) { if (grp == 1) { s0 = a0; s1 = a1; } }
                    if (d == 7) { if (grp == 2) { s0 = a0; s1 = a1; } }
                    if (d == 15) { if (grp == 3) { s0 = a0; s1 = a1; } }
                }
                const float cnt = fminf((float)(t0 + i - tb + 1), wf), inv = 1.0f / cnt;
                const float m0 = s0 * inv - bf_lo(rows[r]), m1 = s1 * inv - bf_hi(rows[r]);
                *(unsigned*)(MIXED + (size_t)(t0 + i) * WP + c0) = cvt_pk_bf16(m0, m1);
            }
        }
        __syncthreads();
    }
}

__global__ void __launch_bounds__(512, 2) fwd_megakernel(Args args) {
    extern __shared__ __attribute__((aligned(16))) unsigned char lds_raw[];
    LAS unsigned char* lds = (LAS unsigned char*)lds_raw;
    cg::grid_group grid = cg::this_grid();
    const int tid = threadIdx.x, lane = tid & 63, wave = __builtin_amdgcn_readfirstlane(tid >> 6);
    const int G = gridDim.x;
    const int lo = args.ph_lo, hi = args.ph_hi;
#ifndef PHASE_MASK
#define PHASE_MASK 0x1fff
#endif
#define IN(k) (((PHASE_MASK >> (k)) & 1) && lo <= (k) && (k) < hi)
#define SEAM(k) do { if (IN(k) && IN((k) + 1)) { asm volatile("s_waitcnt vmcnt(0) lgkmcnt(0)" ::: "memory"); __syncthreads(); \
        if (wave == 0) { __builtin_amdgcn_fence(__ATOMIC_RELEASE, "agent"); asm volatile("s_waitcnt vmcnt(0)" ::: "memory"); } \
        grid.sync(); \
        if (wave == 0) { __builtin_amdgcn_fence(__ATOMIC_ACQUIRE, "agent"); asm volatile("s_waitcnt vmcnt(0)" ::: "memory"); } __syncthreads(); } } while (0)
#define PH_VARS const KArgs ka = kargs(); unsigned char* ws = ka->ws; float* ada = (float*)(ws + WS_ADA); bf16_t* XN = (bf16_t*)(ws + WS_XN); bf16_t* ACT = (bf16_t*)(ws + WS_ACT); const float* x = ka->in[0]; float* out = ka->out; (void)ada; (void)XN; (void)ACT; (void)x; (void)out;

    if (IN(0)) { prologue_phase(lds, wave, lane); }
    SEAM(0);
    if (IN(1)) { PH_VARS norm_phase((LAS float*)lds, x, XN, ka->in[4], ada, 0, (const float*)(ws + WS_PART), ka->in[3], tid, wave, lane); }
    SEAM(1);
    if (IN(2)) { PH_VARS pg8::Gemm g{XN, (const bf16_t*)(ws + WS_W1IN), M, 2 * FF, D, D, D, 0, 0}; pg8::StaticOrder S; S.init(M, 2 * FF, G, (int)blockIdx.x);
        pg8::EpiSwiGLU E{ACT}; pg8::gemm_phase(lds, g, S, E); }
    SEAM(2);
    if (IN(3)) { PH_VARS pg8::Gemm g{ACT, (const bf16_t*)(ws + WS_W1OUT), M, D, FF, FF, FF, 0, 0}; pg8::StaticOrder S; S.init(M, D, G, (int)blockIdx.x);
        pg8::EpiResid E{x, out, ada + 0 * 6144 + 2 * D, 0.5f}; pg8::gemm_phase(lds, g, S, E); }
    SEAM(3);
    if (IN(4)) { PH_VARS norm_phase((LAS float*)lds, out, XN, ka->in[7], ada, 1, nullptr, nullptr, tid, wave, lane); }
    SEAM(4);
    if (IN(5)) { PH_VARS pg8::Gemm g{XN, (const bf16_t*)(ws + WS_WIN), M, NIN, D, D, D, 0, 0}; pg8::StaticOrder S; S.init(M, NIN, G, (int)blockIdx.x);
        pg8::EpiMixIn E{(bf16_t*)(ws + WS_GLU), (bf16_t*)(ws + WS_POOLIN), (bf16_t*)(ws + WS_GATEA), (bf16_t*)(ws + WS_GATEB)}; pg8::gemm_phase(lds, g, S, E); }
    SEAM(5);
    if (IN(6)) { PH_VARS convpool_phase((LAS float*)lds, (const bf16_t*)(ws + WS_GLU), (const bf16_t*)(ws + WS_POOLIN), ka->in[9], ka->in[10], ka->in[11], ka->in[12], (bf16_t*)(ws + WS_AACT), (bf16_t*)(ws + WS_MIXED), tid, wave, lane); }
    SEAM(6);
    if (IN(7)) { PH_VARS
        pg8::StaticOrder S; S.init(M, D, G, (int)blockIdx.x);
        { pg8::Gemm g{(const bf16_t*)(ws + WS_MIXED), (const bf16_t*)(ws + WS_WB), M, D, 256, WP, 256, 1, 512};
          pg8::EpiMixOut<true> E{(const bf16_t*)(ws + WS_GATEB), ka->in[16], ka->in[17], nullptr, (bf16_t*)(ws + WS_TMP)}; pg8::gemm_phase(lds, g, S, E); }
        { pg8::Gemm g{(const bf16_t*)(ws + WS_AACT), (const bf16_t*)(ws + WS_WAOUT), M, D, WC, WC, WC, 0, 0};
          pg8::EpiMixOut<false> E{(const bf16_t*)(ws + WS_GATEA), ka->in[14], nullptr, (const bf16_t*)(ws + WS_TMP), (bf16_t*)(ws + WS_MIXM)}; pg8::gemm_phase(lds, g, S, E); }
    }
    SEAM(7);
    if (IN(8)) { PH_VARS pg8::Gemm g{(const bf16_t*)(ws + WS_MIXM), (const bf16_t*)(ws + WS_WOUT), M, D, D, D, D, 0, 0}; pg8::StaticOrder S; S.init(M, D, G, (int)blockIdx.x);
        pg8::EpiResid E{out, out, ada + 1 * 6144 + 2 * D, 1.0f}; pg8::gemm_phase(lds, g, S, E); }
    SEAM(8);
    if (IN(9)) { PH_VARS norm_phase((LAS float*)lds, out, XN, ka->in[19], ada, 2, nullptr, nullptr, tid, wave, lane); }
    SEAM(9);
    if (IN(10)) { PH_VARS pg8::Gemm g{XN, (const bf16_t*)(ws + WS_W2IN), M, 2 * FF, D, D, D, 0, 0}; pg8::StaticOrder S; S.init(M, 2 * FF, G, (int)blockIdx.x);
        pg8::EpiSwiGLU E{ACT}; pg8::gemm_phase(lds, g, S, E); }
    SEAM(10);
    if (IN(11)) { PH_VARS pg8::Gemm g{ACT, (const bf16_t*)(ws + WS_W2OUT), M, D, FF, FF, FF, 0, 0}; pg8::StaticOrder S; S.init(M, D, G, (int)blockIdx.x);
        pg8::EpiResid E{out, out, ada + 2 * 6144 + 2 * D, 0.5f}; pg8::gemm_phase(lds, g, S, E); }
    SEAM(11);
    if (IN(12)) { PH_VARS final_norm_phase(out, ka->in[22], wave, lane); }
#undef IN
#undef SEAM
}

extern "C" void kernel_launch(void* const* d_in, const int* in_sizes, int n_in, void* d_out, int out_size, void* d_ws, size_t ws_size, hipStream_t stream) {
    static int grid = 0;
    if (grid == 0) {
        if (n_in != 23 || in_sizes[0] != M * D || out_size != M * D || ws_size < WS_END) { fprintf(stderr, "kernel_launch: unexpected shapes (n_in %d, in0 %d, out %d, ws %zu); nothing launched\n", n_in, n_in > 0 ? in_sizes[0] : -1, out_size, ws_size); grid = -1; return; }
        int dev = 0, cus = 0, per_cu = 0;
        if (hipGetDevice(&dev) != hipSuccess || hipDeviceGetAttribute(&cus, hipDeviceAttributeMultiprocessorCount, dev) != hipSuccess) { fprintf(stderr, "kernel_launch: device query failed\n"); grid = -1; return; }
        if (hipFuncSetAttribute((const void*)fwd_megakernel, hipFuncAttributeMaxDynamicSharedMemorySize, LDS_BYTES) != hipSuccess) { fprintf(stderr, "kernel_launch: hipFuncSetAttribute failed\n"); grid = -1; return; }
        if (hipOccupancyMaxActiveBlocksPerMultiprocessor(&per_cu, (const void*)fwd_megakernel, 512, LDS_BYTES) != hipSuccess || per_cu < 1) { fprintf(stderr, "kernel_launch: occupancy query gives %d blocks per CU\n", per_cu); per_cu = 1; }
        (void)hipGetLastError();
        grid = cus * 1;
        fprintf(stderr, "kernel_launch: grid %d (cus %d, per_cu %d)\n", grid, cus, per_cu);
    }
    if (grid < 0) return;
    Args a{};
    for (int i = 0; i < 23; ++i) a.in[i] = (const float*)d_in[i];
    a.out = (float*)d_out; a.ws = (unsigned char*)d_ws;
#if MK_N_LAUNCHES == 1
    a.ph_lo = 0; a.ph_hi = NPH;
    void* kargs[] = {&a};
    hipError_t e = hipLaunchCooperativeKernel((const void*)fwd_megakernel, dim3(grid), dim3(512), kargs, LDS_BYTES, stream);
    if (e != hipSuccess) fprintf(stderr, "kernel_launch: cooperative launch failed: %s (grid %d)\n", hipGetErrorString(e), grid);
#else
    for (int p = 0; p < NPH; ++p) {
        a.ph_lo = p; a.ph_hi = p + 1;
        hipLaunchKernelGGL(fwd_megakernel, dim3(grid), dim3(512), LDS_BYTES, stream, a);
    }
#endif
}
```

```cpp
#include <hip/hip_runtime.h>
#include <hip/hip_cooperative_groups.h>
#include <cstdio>
#include <cstdint>
namespace cg = cooperative_groups;

#define LAS __attribute__((address_space(3)))
typedef unsigned short bf16_t;
typedef short bf16x8 __attribute__((ext_vector_type(8)));
typedef float f32x4 __attribute__((ext_vector_type(4)));
typedef float f32x2 __attribute__((ext_vector_type(2)));
typedef unsigned u32x4 __attribute__((ext_vector_type(4)));
typedef unsigned u32x2 __attribute__((ext_vector_type(2)));

#ifndef MK_N_LAUNCHES
#define MK_N_LAUNCHES 1
#endif

constexpr int BATCH = 2, SEQ = 4096, D = 2048, M = BATCH * SEQ, FF = 5632, WC = 1024, WP = 1024, NIN = 7168, NADA = 18432, CONVK = 31;
constexpr float EPS = 1e-6f;
constexpr int NPH = 13;
constexpr int ADA_KC = 8, ADA_CC = NADA / 256, ADA_ITEMS = ADA_KC * ADA_CC;

constexpr size_t MiB = 1u << 20;
constexpr size_t WS_PART = 0, WS_ADA = 2 * MiB, WS_BAR = 3 * MiB, BAR_BYTES = 16384;
constexpr size_t WS_W1IN = 4 * MiB, WS_W1OUT = 48 * MiB, WS_WIN = 70 * MiB, WS_WAOUT = 98 * MiB, WS_WB = 102 * MiB, WS_WOUT = 103 * MiB, WS_W2IN = 111 * MiB, WS_W2OUT = 155 * MiB;
constexpr size_t WS_XN = 178 * MiB, WS_ACT = 210 * MiB, WS_GLU = 298 * MiB, WS_POOLIN = 314 * MiB, WS_GATEA = 330 * MiB, WS_GATEB = 362 * MiB;
constexpr size_t WS_AACT = 394 * MiB, WS_MIXED = 410 * MiB, WS_MIXM = 426 * MiB, WS_TMP = 458 * MiB, WS_END = 490 * MiB;

constexpr int LDS_BYTES = 147456;

__device__ __forceinline__ unsigned cvt_pk_bf16(float lo, float hi) { unsigned r; asm volatile("v_cvt_pk_bf16_f32 %0, %1, %2" : "=v"(r) : "v"(lo), "v"(hi)); return r; }
__device__ __forceinline__ float bf_lo(unsigned u) { return __uint_as_float(u << 16); }
__device__ __forceinline__ float bf_hi(unsigned u) { return __uint_as_float(u & 0xffff0000u); }
__device__ __forceinline__ float sigm(float x) { return __builtin_amdgcn_rcpf(1.0f + __expf(-x)); }
__device__ __forceinline__ float wave_sum(float v) {
#pragma unroll
    for (int o = 1; o < 64; o <<= 1) v += __shfl_xor(v, o);
    return v;
}

namespace pg8 {
constexpr int BM = 256, BK = 64, HALF = 128, HTB = HALF * BK * 2, STAGE_BYTES = 8 * HTB, NXCD = 8, WGM = 8;

__host__ __device__ __forceinline__ int lds_byte(int r, int c) { const int st = (r >> 4) * 2 + (c >> 5), rr = r & 15, cc = c & 31, ob = rr * 64 + cc * 2; return st * 1024 + (ob ^ (((ob >> 9) & 1) << 5)); }
__host__ __device__ __forceinline__ void stage_rc(int b, int& R, int& C) { const int st = b / 1024, sb = b % 1024, swz = sb ^ (((sb >> 9) & 1) << 5); R = (st >> 1) * 16 + swz / 64; C = (st & 1) * 32 + (swz % 64) / 2; }
__host__ __device__ __forceinline__ int perm32(int rho) { const int n = rho >> 4, i = rho & 15; return 8 * (i >> 2) + 4 * n + (i & 3); }

struct Unit { int pm, pn; };
struct Gemm { const bf16_t* A; const bf16_t* Bt; int M, N, K, lda, ldb, agshift, agbytes; };

struct StaticOrder {
    int nM, nN, nwg, G, c;
    __host__ __device__ void init(int M_, int N_, int G_, int c_) { nM = M_ / BM; nN = N_ / BM; nwg = nM * nN; G = G_; c = c_; }
    __host__ __device__ bool next(int i, Unit& u) const {
        const long L = (long)i * G + c; if (L >= nwg) return false;
        int wgid = (int)L; { const int q = nwg / NXCD, r = nwg % NXCD, xcd = wgid % NXCD, off = wgid / NXCD; wgid = (xcd < r ? xcd * (q + 1) : r * (q + 1) + (xcd - r) * q) + off; }
        const int nig = WGM * nN, gid = wgid / nig, fm = gid * WGM, gsz = (nM - fm) < WGM ? (nM - fm) : WGM;
        u.pm = fm + ((wgid % nig) % gsz); u.pn = (wgid % nig) / gsz; return true;
    }
};


template <int MODE>
__device__ __forceinline__ void pair_store(const f32x4 (&acc)[2][2][4][2], const Unit& u, int wr, int wc, int fr, int fq, bf16_t* O, int ldc, int ct) {
    const int row0 = u.pm * BM + wr * 64 + fr, col0 = ct * 128 + wc * 32 + 8 * fq;
#pragma unroll
    for (int ai = 0; ai < 2; ++ai)
#pragma unroll
        for (int m = 0; m < 4; ++m) {
            bf16_t* rowp = O + (size_t)(row0 + ai * HALF + m * 16) * ldc + col0;
            float o[8];
#pragma unroll
            for (int n = 0; n < 2; ++n)
#pragma unroll
                for (int e = 0; e < 4; ++e) { const float p = acc[ai][0][m][n][e], q = acc[ai][1][m][n][e]; o[n * 4 + e] = (MODE == 0) ? p * sigm(p) * q : p * sigm(q); }
            u32x4 w; w.x = cvt_pk_bf16(o[0], o[1]); w.y = cvt_pk_bf16(o[2], o[3]); w.z = cvt_pk_bf16(o[4], o[5]); w.w = cvt_pk_bf16(o[6], o[7]);
            *(u32x4*)rowp = w;
        }
}
template <int ACT>
__device__ __forceinline__ void tile_store(const f32x4 (&acc)[2][2][4][2], const Unit& u, int wr, int wc, int fr, int fq, bf16_t* O, int ldc, int colt) {
    const int row0 = u.pm * BM + wr * 64 + fr, col0 = colt + wc * 32 + 8 * fq;
#pragma unroll
    for (int ai = 0; ai < 2; ++ai)
#pragma unroll
        for (int m = 0; m < 4; ++m) {
            bf16_t* rowp = O + (size_t)(row0 + ai * HALF + m * 16) * ldc + col0;
#pragma unroll
            for (int bj = 0; bj < 2; ++bj) {
                f32x4 v0 = acc[ai][bj][m][0], v1 = acc[ai][bj][m][1];
                if (ACT == 1) {
#pragma unroll
                    for (int e = 0; e < 4; ++e) { v0[e] = sigm(v0[e]); v1[e] = sigm(v1[e]); }
                }
                u32x4 w; w.x = cvt_pk_bf16(v0[0], v0[1]); w.y = cvt_pk_bf16(v0[2], v0[3]); w.z = cvt_pk_bf16(v1[0], v1[1]); w.w = cvt_pk_bf16(v1[2], v1[3]);
                *(u32x4*)(rowp + bj * HALF) = w;
            }
        }
}

struct EpiSwiGLU {
    static constexpr bool PERM = true;
    bf16_t* O;
    __device__ __forceinline__ void operator()(const f32x4 (&acc)[2][2][4][2], const Unit& u, int wr, int wc, int fr, int fq) const { pair_store<0>(acc, u, wr, wc, fr, fq, O, FF, u.pn); }
};
struct EpiMixIn {
    static constexpr bool PERM = true;
    bf16_t *glu, *poolin, *gatea, *gateb;
    __device__ __forceinline__ void operator()(const f32x4 (&acc)[2][2][4][2], const Unit& u, int wr, int wc, int fr, int fq) const {
        if (u.pn < 8) pair_store<1>(acc, u, wr, wc, fr, fq, glu, WC, u.pn);
        else if (u.pn < 12) tile_store<0>(acc, u, wr, wc, fr, fq, poolin, WP, (u.pn - 8) * BM);
        else if (u.pn < 20) tile_store<0>(acc, u, wr, wc, fr, fq, gatea, D, (u.pn - 12) * BM);
        else tile_store<0>(acc, u, wr, wc, fr, fq, gateb, D, (u.pn - 20) * BM);
    }
};
struct EpiResid {
    static constexpr bool PERM = false;
    const float* base; float* out; const float* gate; float s;
    __device__ __forceinline__ void operator()(const f32x4 (&acc)[2][2][4][2], const Unit& u, int wr, int wc, int fr, int fq) const {
        const int b = u.pm >> 4, col0 = u.pn * BM + wc * 32 + 4 * fq;
        const float* gp = gate + (size_t)b * NADA + col0;
        f32x4 gv[2][2];
#pragma unroll
        for (int bj = 0; bj < 2; ++bj)
#pragma unroll
            for (int n = 0; n < 2; ++n) gv[bj][n] = *(const f32x4*)(gp + bj * HALF + n * 16) * s;
#pragma unroll
        for (int ai = 0; ai < 2; ++ai)
#pragma unroll
            for (int m = 0; m < 4; ++m) {
                const size_t off = (size_t)(u.pm * BM + ai * HALF + wr * 64 + m * 16 + fr) * D + col0;
#pragma unroll
                for (int bj = 0; bj < 2; ++bj)
#pragma unroll
                    for (int n = 0; n < 2; ++n) { const f32x4 bs = *(const f32x4*)(base + off + bj * HALF + n * 16); *(f32x4*)(out + off + bj * HALF + n * 16) = bs + gv[bj][n] * acc[ai][bj][m][n]; }
                if (m & 1) asm volatile("" ::: "memory");
            }
    }
};
template <bool FIRST>
struct EpiMixOut {
    static constexpr bool PERM = true;
    const bf16_t* gatev; const float* bias; const float* ls; const bf16_t* tmp_in; bf16_t* O;
    __device__ __forceinline__ void operator()(const f32x4 (&acc)[2][2][4][2], const Unit& u, int wr, int wc, int fr, int fq) const {
        const int row0 = u.pm * BM + wr * 64 + fr, col0 = u.pn * BM + wc * 32 + 8 * fq;
#pragma unroll
        for (int ai = 0; ai < 2; ++ai)
#pragma unroll
            for (int m = 0; m < 4; ++m) {
                const size_t off = (size_t)(row0 + ai * HALF + m * 16) * D + col0;
#pragma unroll
                for (int bj = 0; bj < 2; ++bj) {
                    const u32x4 gw = *(const u32x4*)(gatev + off + bj * HALF);
                    const f32x4 b0 = *(const f32x4*)(bias + col0 + bj * HALF), b1 = *(const f32x4*)(bias + col0 + bj * HALF + 4);
                    f32x4 v0 = acc[ai][bj][m][0] + b0, v1 = acc[ai][bj][m][1] + b1;
                    const f32x4 g0 = (f32x4){sigm(bf_lo(gw.x)), sigm(bf_hi(gw.x)), sigm(bf_lo(gw.y)), sigm(bf_hi(gw.y))}, g1 = (f32x4){sigm(bf_lo(gw.z)), sigm(bf_hi(gw.z)), sigm(bf_lo(gw.w)), sigm(bf_hi(gw.w))};
                    if (FIRST) { const f32x4 l0 = *(const f32x4*)(ls + col0 + bj * HALF), l1 = *(const f32x4*)(ls + col0 + bj * HALF + 4); v0 = v0 * l0 * g0; v1 = v1 * l1 * g1; }
                    else {
                        const u32x4 tw = *(const u32x4*)(tmp_in + off + bj * HALF);
                        v0 = v0 * g0 + (f32x4){bf_lo(tw.x), bf_hi(tw.x), bf_lo(tw.y), bf_hi(tw.y)};
                        v1 = v1 * g1 + (f32x4){bf_lo(tw.z), bf_hi(tw.z), bf_lo(tw.w), bf_hi(tw.w)};
                    }
                    u32x4 w; w.x = cvt_pk_bf16(v0[0], v0[1]); w.y = cvt_pk_bf16(v0[2], v0[3]); w.z = cvt_pk_bf16(v1[0], v1[1]); w.w = cvt_pk_bf16(v1[2], v1[3]);
                    *(u32x4*)(O + off + bj * HALF) = w;
                }
                asm volatile("" ::: "memory");
            }
    }
};

template <class Epi>
__device__ __forceinline__ void gemm_phase(LAS unsigned char* lds, const Gemm g, const StaticOrder& S, const Epi& E) {
    const int tid = threadIdx.x, wid = __builtin_amdgcn_readfirstlane(tid >> 6), lane = tid & 63, wr = wid >> 2, wc = wid & 3, fr = lane & 15, fq = lane >> 4;
    const int K = g.K, nt = K / BK;
    unsigned voffA[2], voffB[2];
#pragma unroll
    for (int i = 0; i < 2; ++i) { int R, C; stage_rc(tid * 16 + i * 8192, R, C); const int Rb = Epi::PERM ? ((R & ~31) + perm32(R & 31)) : R;
        voffA[i] = (unsigned)(R * g.lda + C) * 2u; voffB[i] = (unsigned)(Rb * g.ldb + C) * 2u; }
    const size_t kstep = (size_t)(BK * 2);
    const size_t hstepA = (size_t)HALF * g.lda * 2, hstepB = (size_t)HALF * g.ldb * 2;
    const size_t tstepA = 2 * hstepA, tstepB = 2 * hstepB;
    const unsigned ldsw = (unsigned)wid * 1024u;
    const int aoff = lds_byte(wr * 64 + fr, fq * 8), boff = lds_byte(wc * 32 + fr, fq * 8);
#define PG8_SA(b, h) (((b) * 2 + (h)) * HTB)
#define PG8_SB(b, h) ((4 + (b) * 2 + (h)) * HTB)
#define PG8_STAGE(bufoff, gbase, voff) do { _Pragma("unroll") for (int _i = 0; _i < 2; ++_i) \
        __builtin_amdgcn_global_load_lds((const unsigned*)((const char*)(gbase) + (voff)[_i]), (LAS unsigned*)(lds + (bufoff) + ldsw + _i * 8192), 16, 0, 0); } while (0)
#define PG8_LDA(dst, b, h) do { _Pragma("unroll") for (int m = 0; m < 4; ++m) _Pragma("unroll") for (int k = 0; k < 2; ++k) dst[m][k] = *(const LAS bf16x8*)(lds + PG8_SA(b, h) + aoff + m * 2048 + k * 1024); } while (0)
#define PG8_LDB(dst, b, h) do { _Pragma("unroll") for (int n = 0; n < 2; ++n) _Pragma("unroll") for (int k = 0; k < 2; ++k) dst[n][k] = *(const LAS bf16x8*)(lds + PG8_SB(b, h) + boff + n * 2048 + k * 1024); } while (0)
#define PG8_MMA(ai, bj, At, Bt) do { __builtin_amdgcn_s_setprio(1); _Pragma("unroll") for (int m = 0; m < 4; ++m) _Pragma("unroll") for (int n = 0; n < 2; ++n) _Pragma("unroll") for (int k = 0; k < 2; ++k) \
        acc[ai][bj][m][n] = __builtin_amdgcn_mfma_f32_16x16x32_bf16(Bt[n][k], At[m][k], acc[ai][bj][m][n], 0, 0, 0); __builtin_amdgcn_s_setprio(0); } while (0)
#define PG8_WAIT_V(n) asm volatile("s_waitcnt vmcnt(" #n ")" ::: "memory")
#define PG8_WAIT_L(n) asm volatile("s_waitcnt lgkmcnt(" #n ")" ::: "memory")
#define PG8_BAR __builtin_amdgcn_s_barrier()
#define PG8_SCHED __builtin_amdgcn_sched_barrier(0)
    Unit cur, nxt; int ui = 0;
    if (!S.next(0, cur)) return;
    f32x4 acc[2][2][4][2];
#pragma unroll
    for (int a = 0; a < 2; ++a)
#pragma unroll
        for (int b = 0; b < 2; ++b)
#pragma unroll
            for (int m = 0; m < 4; ++m)
#pragma unroll
                for (int n = 0; n < 2; ++n) acc[a][b][m][n] = (f32x4){0.f, 0.f, 0.f, 0.f};
    bf16x8 At[4][2], B0[2][2], B1[2][2];
    const char* cA = (const char*)g.A + (size_t)cur.pm * tstepA + (size_t)(cur.pn >> g.agshift) * g.agbytes; const char* cB = (const char*)g.Bt + (size_t)cur.pn * tstepB;
    PG8_STAGE(PG8_SB(0, 0), cB, voffB); PG8_STAGE(PG8_SB(0, 1), cB + hstepB, voffB); PG8_STAGE(PG8_SA(0, 0), cA, voffA); PG8_STAGE(PG8_SA(0, 1), cA + hstepA, voffA);
    if (wr == 1) PG8_BAR;
    PG8_WAIT_V(2); PG8_BAR;
    PG8_STAGE(PG8_SB(1, 0), cB + kstep, voffB); PG8_STAGE(PG8_SA(1, 0), cA + kstep, voffA); PG8_STAGE(PG8_SB(1, 1), cB + hstepB + kstep, voffB);
    PG8_WAIT_V(6); PG8_BAR;
    for (;;) {
        const bool has_next = S.next(ui + 1, nxt);
        const char* nA = has_next ? (const char*)g.A + (size_t)nxt.pm * tstepA + (size_t)(nxt.pn >> g.agshift) * g.agbytes : cA; const char* nB = has_next ? (const char*)g.Bt + (size_t)nxt.pn * tstepB : cB;
#pragma unroll 1
        for (int t = 0; t < nt; t += 2) {
            const bool last = (t == nt - 2);
            const char* a1 = cA + (size_t)(t + 1) * kstep;
            const char* a2 = last ? nA : cA + (size_t)(t + 2) * kstep; const char* b2 = last ? nB : cB + (size_t)(t + 2) * kstep;
            const char* a3 = a2 + kstep; const char* b3 = b2 + kstep;
            PG8_LDB(B0, 0, 0); PG8_LDB(B1, 0, 1); PG8_SCHED; PG8_LDA(At, 0, 0); PG8_STAGE(PG8_SA(1, 1), a1 + hstepA, voffA);
            PG8_WAIT_V(8); PG8_WAIT_L(0); PG8_BAR; PG8_MMA(0, 0, At, B0); PG8_MMA(0, 1, At, B1); PG8_BAR; PG8_SCHED;
            PG8_LDA(At, 0, 1); PG8_STAGE(PG8_SB(0, 0), b2, voffB); PG8_STAGE(PG8_SB(0, 1), b2 + hstepB, voffB); PG8_STAGE(PG8_SA(0, 0), a2, voffA);
            PG8_WAIT_V(8); PG8_WAIT_L(0); PG8_BAR; PG8_MMA(1, 0, At, B0); PG8_MMA(1, 1, At, B1); PG8_BAR; PG8_SCHED;
            PG8_LDB(B0, 1, 0); PG8_LDB(B1, 1, 1); PG8_SCHED; PG8_LDA(At, 1, 0); PG8_STAGE(PG8_SA(0, 1), a2 + hstepA, voffA);
            PG8_WAIT_V(8); PG8_WAIT_L(0); PG8_BAR; PG8_MMA(0, 0, At, B0); PG8_MMA(0, 1, At, B1); PG8_BAR; PG8_SCHED;
            PG8_LDA(At, 1, 1); PG8_STAGE(PG8_SB(1, 0), b3, voffB); PG8_STAGE(PG8_SB(1, 1), b3 + hstepB, voffB); PG8_STAGE(PG8_SA(1, 0), a3, voffA);
            PG8_WAIT_V(8); PG8_WAIT_L(0); PG8_BAR; PG8_MMA(1, 0, At, B0); PG8_MMA(1, 1, At, B1); PG8_BAR; PG8_SCHED;
        }
        if (wr == 0) PG8_BAR;
        asm volatile("" ::: "memory");
        E(acc, cur, wr, wc, fr, fq);
        asm volatile("" ::: "memory");
        if (!has_next) break;
#pragma unroll
        for (int a = 0; a < 2; ++a)
#pragma unroll
            for (int b = 0; b < 2; ++b)
#pragma unroll
                for (int m = 0; m < 4; ++m)
#pragma unroll
                    for (int n = 0; n < 2; ++n) acc[a][b][m][n] = (f32x4){0.f, 0.f, 0.f, 0.f};
        cur = nxt; cA = nA; cB = nB; ++ui;
        if (wr == 1) PG8_BAR;
    }
    PG8_WAIT_V(0);
    PG8_BAR;
#undef PG8_SA
#undef PG8_SB
#undef PG8_STAGE
#undef PG8_LDA
#undef PG8_LDB
#undef PG8_MMA
#undef PG8_WAIT_V
#undef PG8_WAIT_L
#undef PG8_BAR
#undef PG8_SCHED
}
}

__device__ __forceinline__ void tr_tile(const float* __restrict__ W, int N, int k0, int n0, bf16_t* __restrict__ WT, int ldk, int drow0, LAS unsigned* scr, int lane) {
    const int l16 = lane & 15, lq = lane >> 4;
    f32x4 v[16];
#pragma unroll
    for (int i = 0; i < 16; ++i) { const int kk = 8 * (i >> 1) + 2 * lq + (i & 1); v[i] = __builtin_nontemporal_load((const f32x4*)(W + (size_t)(k0 + kk) * N + n0 + 4 * l16)); }
#pragma unroll
    for (int p = 0; p < 8; ++p) {
        const f32x4 a = v[2 * p], b = v[2 * p + 1];
        const int chunk = (p ^ (l16 & 7)) * 4 + lq;
#pragma unroll
        for (int j = 0; j < 4; ++j) scr[(4 * l16 + j) * 32 + chunk] = cvt_pk_bf16(a[j], b[j]);
    }
    asm volatile("s_waitcnt lgkmcnt(0)" ::: "memory");
#pragma unroll
    for (int jj = 0; jj < 8; ++jj) {
        const int n = (lane >> 3) + 8 * jj, c = lane & 7;
        const u32x4 o = *(const LAS u32x4*)(scr + n * 32 + ((c ^ ((n >> 2) & 7)) * 4));
        *(u32x4*)(WT + (size_t)(drow0 + n) * ldk + k0 + 8 * c) = o;
    }
    asm volatile("s_waitcnt lgkmcnt(0)" ::: "memory");
}
__device__ __forceinline__ void tr_item(const float* W, int K, int N, bf16_t* WT, int ph, int r, LAS unsigned* scr, int lane) {
    const int nblk = N >> 6, kb = r / nblk, nb = r - kb * nblk, n0 = nb << 6;
    int drow0 = n0;
    if (n0 < 2 * ph) { const int second = n0 >= ph, j = n0 - (second ? ph : 0); drow0 = 256 * (j >> 7) + 128 * second + (j & 127); }
    tr_tile(W, N, kb << 6, n0, WT, K, drow0, scr, lane);
}
__device__ __forceinline__ void ada_item(const float* __restrict__ c, const float* __restrict__ w_ada, float* __restrict__ part, int item, int lane) {
    const int kc = item / ADA_CC, cc = item - kc * ADA_CC, k0 = kc * 256, col = cc * 256 + 4 * lane;
    float s0[4], s1[4];
#pragma unroll
    for (int q = 0; q < 4; ++q) { const float a = c[k0 + 64 * q + lane], b = c[D + k0 + 64 * q + lane]; s0[q] = a * sigm(a); s1[q] = b * sigm(b); }
    f32x4 acc0 = {0.f, 0.f, 0.f, 0.f}, acc1 = {0.f, 0.f, 0.f, 0.f};
    const float* wp = w_ada + (size_t)k0 * NADA + col;
#pragma unroll
    for (int q = 0; q < 4; ++q) {
        for (int l0 = 0; l0 < 64; l0 += 16) {
            f32x4 w[16];
#pragma unroll
            for (int i = 0; i < 16; ++i) w[i] = __builtin_nontemporal_load((const f32x4*)(wp + (size_t)(64 * q + l0 + i) * NADA));
#pragma unroll
            for (int i = 0; i < 16; ++i) {
                const float a = __uint_as_float(__builtin_amdgcn_readlane(__float_as_uint(s0[q]), l0 + i)), b = __uint_as_float(__builtin_amdgcn_readlane(__float_as_uint(s1[q]), l0 + i));
                acc0 += w[i] * a; acc1 += w[i] * b;
            }
        }
    }
    *(f32x4*)(part + (size_t)(kc * 2 + 0) * NADA + col) = acc0;
    *(f32x4*)(part + (size_t)(kc * 2 + 1) * NADA + col) = acc1;
}

struct Args { const float* in[23]; float* out; unsigned char* ws; int ph_lo, ph_hi, dump_sel, pad; };
typedef const __attribute__((address_space(4))) Args* KArgs;
__device__ __forceinline__ KArgs kargs() { KArgs p = (KArgs)__builtin_amdgcn_kernarg_segment_ptr(); asm volatile("" : "+s"(p)); return p; }

__device__ __forceinline__ void prologue_phase(LAS unsigned char* lds, int wave, int lane) {
    const KArgs ka = kargs();
    const int gw = blockIdx.x * 8 + wave, NGW = gridDim.x * 8;
    unsigned char* ws = ka->ws;
    LAS unsigned* scr = (LAS unsigned*)(lds + wave * 16384);
    constexpr int T_1IN = (D / 64) * (2 * FF / 64), T_1OUT = (FF / 64) * (D / 64), T_IN = (D / 64) * (NIN / 64), T_AOUT = (WC / 64) * (D / 64), T_B = (256 / 64) * (512 / 64), T_OUT = (D / 64) * (D / 64);
    constexpr int NT = 2 * T_1IN + 2 * T_1OUT + T_IN + T_AOUT + 4 * T_B + T_OUT;
    int first, stride;
    if (NGW > ADA_ITEMS) {
        if (gw < ADA_ITEMS) { ada_item(ka->in[1], ka->in[2], (float*)(ws + WS_PART), gw, lane); return; }
        first = gw - ADA_ITEMS; stride = NGW - ADA_ITEMS;
    } else {
        for (int it = gw; it < ADA_ITEMS; it += NGW) ada_item(ka->in[1], ka->in[2], (float*)(ws + WS_PART), it, lane);
        first = gw; stride = NGW;
    }
    for (int it = first; it < NT; it += stride) {
        int r = it;
        if (r < T_1IN) { tr_item(ka->in[5], D, 2 * FF, (bf16_t*)(ws + WS_W1IN), FF, r, scr, lane); continue; } r -= T_1IN;
        if (r < T_1OUT) { tr_item(ka->in[6], FF, D, (bf16_t*)(ws + WS_W1OUT), 0, r, scr, lane); continue; } r -= T_1OUT;
        if (r < T_IN) { tr_item(ka->in[8], D, NIN, (bf16_t*)(ws + WS_WIN), WC, r, scr, lane); continue; } r -= T_IN;
        if (r < T_AOUT) { tr_item(ka->in[13], WC, D, (bf16_t*)(ws + WS_WAOUT), 0, r, scr, lane); continue; } r -= T_AOUT;
        if (r < 4 * T_B) { const int grp = r / T_B; tr_item(ka->in[15] + (size_t)grp * 256 * 512, 256, 512, (bf16_t*)(ws + WS_WB) + (size_t)grp * 512 * 256, 0, r - grp * T_B, scr, lane); continue; } r -= 4 * T_B;
        if (r < T_OUT) { tr_item(ka->in[18], D, D, (bf16_t*)(ws + WS_WOUT), 0, r, scr, lane); continue; } r -= T_OUT;
        if (r < T_1IN) { tr_item(ka->in[20], D, 2 * FF, (bf16_t*)(ws + WS_W2IN), FF, r, scr, lane); continue; } r -= T_1IN;
        tr_item(ka->in[21], FF, D, (bf16_t*)(ws + WS_W2OUT), 0, r, scr, lane);
    }
}

__device__ __forceinline__ void norm_phase(LAS float* ldsf, const float* __restrict__ src, bf16_t* __restrict__ XN, const float* __restrict__ g, float* ada, int sub, const float* __restrict__ part, const float* __restrict__ b_ada, int tid, int wave, int lane) {
    if (part) {
        for (int idx = blockIdx.x * 512 + tid; idx < BATCH * NADA; idx += gridDim.x * 512) {
            const int b = idx / NADA, j = idx - b * NADA; float s = b_ada[j];
#pragma unroll
            for (int p = 0; p < ADA_KC; ++p) s += part[(size_t)(p * 2 + b) * NADA + j];
            ada[idx] = s;
        }
    }
    for (int rb = blockIdx.x; rb < M / 32; rb += gridDim.x) {
        const int b = rb / (SEQ / 32);
        for (int c = tid; c < D; c += 512) {
            const int jsh = sub * 6144 + c, jsc = jsh + D; float sh, sc;
            if (part) { sh = b_ada[jsh]; sc = b_ada[jsc];
#pragma unroll
                for (int p = 0; p < ADA_KC; ++p) { sh += part[(size_t)(p * 2 + b) * NADA + jsh]; sc += part[(size_t)(p * 2 + b) * NADA + jsc]; } }
            else { sh = ada[(size_t)b * NADA + jsh]; sc = ada[(size_t)b * NADA + jsc]; }
            ldsf[c] = g[c] * (1.0f + sc); ldsf[D + c] = sh;
        }
        __syncthreads();
#pragma unroll 1
        for (int i = 0; i < 4; ++i) {
            const int row = rb * 32 + wave * 4 + i;
            const f32x4* xr = (const f32x4*)(src + (size_t)row * D) + lane;
            f32x4 v[8]; float ss = 0.f;
#pragma unroll
            for (int j = 0; j < 8; ++j) { v[j] = xr[64 * j]; ss += (v[j].x * v[j].x + v[j].y * v[j].y) + (v[j].z * v[j].z + v[j].w * v[j].w); }
            const float rstd = rsqrtf(wave_sum(ss) * (1.0f / D) + EPS);
            u32x2* o8 = (u32x2*)(XN + (size_t)row * D) + lane;
#pragma unroll
            for (int j = 0; j < 8; ++j) {
                const f32x4 av = *(const LAS f32x4*)(ldsf + 4 * lane + 256 * j), sv = *(const LAS f32x4*)(ldsf + D + 4 * lane + 256 * j);
                const f32x4 o = v[j] * rstd * av + sv;
                u32x2 w; w.x = cvt_pk_bf16(o.x, o.y); w.y = cvt_pk_bf16(o.z, o.w); o8[64 * j] = w;
            }
        }
        __syncthreads();
    }
}
__device__ __forceinline__ void final_norm_phase(float* io, const float* __restrict__ g, int wave, int lane) {
    for (int row = blockIdx.x * 8 + wave; row < M; row += gridDim.x * 8) {
        f32x4* xr = (f32x4*)(io + (size_t)row * D) + lane;
        f32x4 v[8]; float ss = 0.f;
#pragma unroll
        for (int j = 0; j < 8; ++j) { v[j] = xr[64 * j]; ss += (v[j].x * v[j].x + v[j].y * v[j].y) + (v[j].z * v[j].z + v[j].w * v[j].w); }
        const float rstd = rsqrtf(wave_sum(ss) * (1.0f / D) + EPS);
#pragma unroll
        for (int j = 0; j < 8; ++j) { const f32x4 gv = *((const f32x4*)g + lane + 64 * j); xr[64 * j] = v[j] * rstd * gv; }
    }
}

__device__ __forceinline__ void convpool_phase(LAS float* ldsf, const bf16_t* __restrict__ GLU, const bf16_t* __restrict__ POOLIN, const float* __restrict__ conv_w, const float* __restrict__ conv_b,
                                               const float* __restrict__ ln_g, const float* __restrict__ ln_b, bf16_t* __restrict__ AACT, bf16_t* __restrict__ MIXED, int tid, int wave, int lane) {
    const int c0 = 2 * tid;
    LAS float* red = ldsf;
    LAS float* stat = ldsf + 256;
    for (int ch = blockIdx.x; ch < M / 16; ch += gridDim.x) {
        const int t0 = ch * 16, tb = t0 & ~(SEQ - 1);
        {
            float w0[CONVK], w1[CONVK];
#pragma unroll
            for (int j = 0; j < CONVK; ++j) { const f32x2 w = *(const f32x2*)(conv_w + j * WC + c0); w0[j] = w.x; w1[j] = w.y; }
            unsigned rows[46];
#pragma unroll
            for (int r = 0; r < 46; ++r) { const int t = t0 - 30 + r; rows[r] = (t >= tb) ? *(const unsigned*)(GLU + (size_t)t * WC + c0) : 0u; }
            const f32x2 cb = *(const f32x2*)(conv_b + c0);
            float o0[16], o1[16];
#pragma unroll
            for (int i = 0; i < 16; ++i) {
                float a0 = cb.x, a1 = cb.y;
#pragma unroll
                for (int j = 0; j < CONVK; ++j) { a0 += bf_lo(rows[i + j]) * w0[j]; a1 += bf_hi(rows[i + j]) * w1[j]; }
                o0[i] = a0; o1[i] = a1;
                const float s = wave_sum(a0 + a1), q = wave_sum(a0 * a0 + a1 * a1);
                if (lane == 0) { red[(i * 8 + wave) * 2] = s; red[(i * 8 + wave) * 2 + 1] = q; }
            }
            __syncthreads();
            if (tid < 16) {
                float s = 0.f, q = 0.f;
#pragma unroll
                for (int w = 0; w < 8; ++w) { s += red[(tid * 8 + w) * 2]; q += red[(tid * 8 + w) * 2 + 1]; }
                const float mean = s * (1.0f / WC), var = fmaxf(q * (1.0f / WC) - mean * mean, 0.f);
                stat[tid * 2] = mean; stat[tid * 2 + 1] = rsqrtf(var + EPS);
            }
            __syncthreads();
            const f32x2 lg = *(const f32x2*)(ln_g + c0), lb = *(const f32x2*)(ln_b + c0);
#pragma unroll
            for (int i = 0; i < 16; ++i) {
                const float mean = stat[i * 2], rstd = stat[i * 2 + 1];
                float y0 = (o0[i] - mean) * rstd * lg.x + lb.x, y1 = (o1[i] - mean) * rstd * lg.y + lb.y;
                y0 = y0 * sigm(y0); y1 = y1 * sigm(y1);
                *(unsigned*)(AACT + (size_t)(t0 + i) * WC + c0) = cvt_pk_bf16(y0, y1);
            }
        }
        {
            const int grp = c0 >> 8; const float wf = (float)(2 << grp);
            unsigned rows[31];
#pragma unroll
            for (int r = 0; r < 31; ++r) { const int t = t0 - 15 + r; rows[r] = (t >= tb) ? *(const unsigned*)(POOLIN + (size_t)t * WP + c0) : 0u; }
#pragma unroll
            for (int i = 0; i < 16; ++i) {
                const int r = 15 + i;
                float a0 = 0.f, a1 = 0.f, s0 = 0.f, s1 = 0.f;
#pragma unroll
                for (int d = 0; d < 16; ++d) {
                    a0 += bf_lo(rows[r - d]); a1 += bf_hi(rows[r - d]);
                    if (d == 1) { if (grp == 0) { s0 = a0; s1 = a1; } }
                    if (d == 3) { if (grp == 1) { s0 = a0; s1 = a1; } }
                    if (d == 7) { if (grp == 2) { s0 = a0; s1 = a1; } }
                    if (d == 15) { if (grp == 3) { s0 = a0; s1 = a1; } }
                }
                const float cnt = fminf((float)(t0 + i - tb + 1), wf), inv = 1.0f / cnt;
                const float m0 = s0 * inv - bf_lo(rows[r]), m1 = s1 * inv - bf_hi(rows[r]);
                *(unsigned*)(MIXED + (size_t)(t0 + i) * WP + c0) = cvt_pk_bf16(m0, m1);
            }
        }
        __syncthreads();
    }
}

#define XB_TMO      128
#define XB_XCNT(j)  (256  + 64 * (j))
#define XB_XSUB(j)  (1280 + 64 * (j))
#define XB_XGEN(j)  (2304 + 64 * (j))
#define XB_TOP      3328
#define XB_TOPGEN   3392
#define XCD_BAR_WORDS 3456
#define XB_SPIN_CAP (1u << 18)
__device__ __forceinline__ unsigned xb_ld(unsigned* p)              { return __hip_atomic_load(p, __ATOMIC_RELAXED, __HIP_MEMORY_SCOPE_AGENT); }
__device__ __forceinline__ unsigned xb_add(unsigned* p, unsigned v) { return __hip_atomic_fetch_add(p, v, __ATOMIC_RELAXED, __HIP_MEMORY_SCOPE_AGENT); }
__device__ __forceinline__ unsigned xb_xcc_id() { return (unsigned)__builtin_amdgcn_s_getreg((3 << 11) | 20) & 0xFu; }
#define XB_SPIN(cond, bar) do { unsigned _sp = 0; while (cond) { __builtin_amdgcn_s_sleep(1); \
    if ((++_sp & 255u) == 0u) { if (xb_ld(&(bar)[XB_TMO])) break; if (_sp > XB_SPIN_CAP) { atomicAdd(&(bar)[XB_TMO], 1u); break; } } } } while (0)
struct XcdBarrier { unsigned* bar; unsigned x; volatile LAS unsigned* st; };
__device__ __forceinline__ XcdBarrier xcd_barrier_post(unsigned* bar, volatile LAS unsigned* st) {
    XcdBarrier b; b.bar = bar; b.x = xb_xcc_id(); b.st = st;
    if (threadIdx.x == 0) (void)xb_add(&bar[XB_XCNT(b.x)], 1u);
    return b;
}
__device__ __forceinline__ void xcd_barrier_complete(unsigned* bar, unsigned x, unsigned& nloc, unsigned& nx) {
    const unsigned G = gridDim.x * gridDim.y * gridDim.z;
    unsigned sum, cnt, mine, sp = 0u;
    for (;;) {
        sum = 0u; cnt = 0u; mine = 0u;
#pragma unroll
        for (unsigned j = 0; j < 16; ++j) { const unsigned c = xb_ld(&bar[XB_XCNT(j)]); sum += c; cnt += (c > 0u) ? 1u : 0u; mine = (j == x) ? c : mine; }
        if (sum == G) break;
        __builtin_amdgcn_s_sleep(1);
        if ((++sp & 255u) == 0u) { if (xb_ld(&bar[XB_TMO])) break; if (sp > XB_SPIN_CAP) { atomicAdd(&bar[XB_TMO], 1u); break; } }
    }
    nloc = mine > 0u ? mine : 1u; nx = cnt > 0u ? cnt : 1u;
}
__device__ __forceinline__ void xcd_barrier(const XcdBarrier& b) {
    asm volatile("s_waitcnt vmcnt(0)" ::: "memory");
    __syncthreads();
    if (threadIdx.x == 0) {
        unsigned* bar = b.bar;
        __builtin_amdgcn_s_waitcnt(0);
        unsigned nloc = b.st[0], nx = b.st[1];
        if (nloc == 0u) { xcd_barrier_complete(bar, b.x, nloc, nx); b.st[0] = nloc; b.st[1] = nx; }
        const unsigned old = xb_add(&bar[XB_XSUB(b.x)], 1u);
        const unsigned gen = old / nloc;
        if (old + 1u == (gen + 1u) * nloc) {
            __builtin_amdgcn_fence(__ATOMIC_RELEASE, "agent");
            asm volatile("s_waitcnt vmcnt(0)" ::: "memory");
            const unsigned og = xb_add(&bar[XB_TOP], 1u);
            const unsigned tg = og / nx;
            if (og + 1u == (tg + 1u) * nx) xb_add(&bar[XB_TOPGEN], 1u);
            else XB_SPIN(xb_ld(&bar[XB_TOPGEN]) == tg, bar);
            __builtin_amdgcn_fence(__ATOMIC_ACQUIRE, "agent");
            xb_add(&bar[XB_XGEN(b.x)], 1u);
            asm volatile("s_waitcnt vmcnt(0)" ::: "memory");
        } else {
            XB_SPIN(xb_ld(&bar[XB_XGEN(b.x)]) == gen, bar);
            __builtin_amdgcn_fence(__ATOMIC_ACQUIRE, "agent");
            asm volatile("s_waitcnt vmcnt(0)" ::: "memory");
        }
    }
    __syncthreads();
}

__global__ void __launch_bounds__(512, 2) fwd_megakernel(Args args) {
    extern __shared__ __attribute__((aligned(16))) unsigned char lds_raw[];
    LAS unsigned char* lds = (LAS unsigned char*)lds_raw;
    cg::grid_group grid = cg::this_grid();
    const int tid = threadIdx.x, lane = tid & 63, wave = __builtin_amdgcn_readfirstlane(tid >> 6);
    const int G = gridDim.x;
    const int lo = args.ph_lo, hi = args.ph_hi;
    if (lo < 0) grid.sync();
    volatile LAS unsigned* misc = (volatile LAS unsigned*)(lds + 131072 + 256);
    if (tid == 0) { misc[0] = 0u; misc[1] = 0u; }
    __syncthreads();
    XcdBarrier bar = xcd_barrier_post((unsigned*)(kargs()->ws + WS_BAR), misc);
#ifndef PHASE_MASK
#define PHASE_MASK 0x1fff
#endif
#define IN(k) (((PHASE_MASK >> (k)) & 1) && lo <= (k) && (k) < hi)
#define SEAM(k) do { if (IN(k) && IN((k) + 1)) xcd_barrier(bar); } while (0)
#define PH_VARS const KArgs ka = kargs(); unsigned char* ws = ka->ws; float* ada = (float*)(ws + WS_ADA); bf16_t* XN = (bf16_t*)(ws + WS_XN); bf16_t* ACT = (bf16_t*)(ws + WS_ACT); const float* x = ka->in[0]; float* out = ka->out; (void)ada; (void)XN; (void)ACT; (void)x; (void)out;

    if (IN(0)) { prologue_phase(lds, wave, lane); }
    SEAM(0);
    if (IN(1)) { PH_VARS norm_phase((LAS float*)lds, x, XN, ka->in[4], ada, 0, (const float*)(ws + WS_PART), ka->in[3], tid, wave, lane); }
    SEAM(1);
    if (IN(2)) { PH_VARS pg8::Gemm g{XN, (const bf16_t*)(ws + WS_W1IN), M, 2 * FF, D, D, D, 0, 0}; pg8::StaticOrder S; S.init(M, 2 * FF, G, (int)blockIdx.x);
        pg8::EpiSwiGLU E{ACT}; pg8::gemm_phase(lds, g, S, E); }
    SEAM(2);
    if (IN(3)) { PH_VARS pg8::Gemm g{ACT, (const bf16_t*)(ws + WS_W1OUT), M, D, FF, FF, FF, 0, 0}; pg8::StaticOrder S; S.init(M, D, G, (int)blockIdx.x);
        pg8::EpiResid E{x, out, ada + 0 * 6144 + 2 * D, 0.5f}; pg8::gemm_phase(lds, g, S, E); }
    SEAM(3);
    if (IN(4)) { PH_VARS norm_phase((LAS float*)lds, out, XN, ka->in[7], ada, 1, nullptr, nullptr, tid, wave, lane); }
    SEAM(4);
    if (IN(5)) { PH_VARS pg8::Gemm g{XN, (const bf16_t*)(ws + WS_WIN), M, NIN, D, D, D, 0, 0}; pg8::StaticOrder S; S.init(M, NIN, G, (int)blockIdx.x);
        pg8::EpiMixIn E{(bf16_t*)(ws + WS_GLU), (bf16_t*)(ws + WS_POOLIN), (bf16_t*)(ws + WS_GATEA), (bf16_t*)(ws + WS_GATEB)}; pg8::gemm_phase(lds, g, S, E); }
    SEAM(5);
    if (IN(6)) { PH_VARS convpool_phase((LAS float*)lds, (const bf16_t*)(ws + WS_GLU), (const bf16_t*)(ws + WS_POOLIN), ka->in[9], ka->in[10], ka->in[11], ka->in[12], (bf16_t*)(ws + WS_AACT), (bf16_t*)(ws + WS_MIXED), tid, wave, lane); }
    SEAM(6);
    if (IN(7)) { PH_VARS
        pg8::StaticOrder S; S.init(M, D, G, (int)blockIdx.x);
        { pg8::Gemm g{(const bf16_t*)(ws + WS_MIXED), (const bf16_t*)(ws + WS_WB), M, D, 256, WP, 256, 1, 512};
          pg8::EpiMixOut<true> E{(const bf16_t*)(ws + WS_GATEB), ka->in[16], ka->in[17], nullptr, (bf16_t*)(ws + WS_TMP)}; pg8::gemm_phase(lds, g, S, E); }
        { pg8::Gemm g{(const bf16_t*)(ws + WS_AACT), (const bf16_t*)(ws + WS_WAOUT), M, D, WC, WC, WC, 0, 0};
          pg8::EpiMixOut<false> E{(const bf16_t*)(ws + WS_GATEA), ka->in[14], nullptr, (const bf16_t*)(ws + WS_TMP), (bf16_t*)(ws + WS_MIXM)}; pg8::gemm_phase(lds, g, S, E); }
    }
    SEAM(7);
    if (IN(8)) { PH_VARS pg8::Gemm g{(const bf16_t*)(ws + WS_MIXM), (const bf16_t*)(ws + WS_WOUT), M, D, D, D, D, 0, 0}; pg8::StaticOrder S; S.init(M, D, G, (int)blockIdx.x);
        pg8::EpiResid E{out, out, ada + 1 * 6144 + 2 * D, 1.0f}; pg8::gemm_phase(lds, g, S, E); }
    SEAM(8);
    if (IN(9)) { PH_VARS norm_phase((LAS float*)lds, out, XN, ka->in[19], ada, 2, nullptr, nullptr, tid, wave, lane); }
    SEAM(9);
    if (IN(10)) { PH_VARS pg8::Gemm g{XN, (const bf16_t*)(ws + WS_W2IN), M, 2 * FF, D, D, D, 0, 0}; pg8::StaticOrder S; S.init(M, 2 * FF, G, (int)blockIdx.x);
        pg8::EpiSwiGLU E{ACT}; pg8::gemm_phase(lds, g, S, E); }
    SEAM(10);
    if (IN(11)) { PH_VARS pg8::Gemm g{ACT, (const bf16_t*)(ws + WS_W2OUT), M, D, FF, FF, FF, 0, 0}; pg8::StaticOrder S; S.init(M, D, G, (int)blockIdx.x);
        pg8::EpiResid E{out, out, ada + 2 * 6144 + 2 * D, 0.5f}; pg8::gemm_phase(lds, g, S, E); }
    SEAM(11);
    if (IN(12)) { PH_VARS final_norm_phase(out, ka->in[22], wave, lane); }
#undef IN
#undef SEAM
}

extern "C" void kernel_launch(void* const* d_in, const int* in_sizes, int n_in, void* d_out, int out_size, void* d_ws, size_t ws_size, hipStream_t stream) {
    static int grid = 0;
    if (grid == 0) {
        if (n_in != 23 || in_sizes[0] != M * D || out_size != M * D || ws_size < WS_END) { fprintf(stderr, "kernel_launch: unexpected shapes (n_in %d, in0 %d, out %d, ws %zu); nothing launched\n", n_in, n_in > 0 ? in_sizes[0] : -1, out_size, ws_size); grid = -1; return; }
        int dev = 0, cus = 0, per_cu = 0;
        if (hipGetDevice(&dev) != hipSuccess || hipDeviceGetAttribute(&cus, hipDeviceAttributeMultiprocessorCount, dev) != hipSuccess) { fprintf(stderr, "kernel_launch: device query failed\n"); grid = -1; return; }
        if (hipFuncSetAttribute((const void*)fwd_megakernel, hipFuncAttributeMaxDynamicSharedMemorySize, LDS_BYTES) != hipSuccess) { fprintf(stderr, "kernel_launch: hipFuncSetAttribute failed\n"); grid = -1; return; }
        if (hipOccupancyMaxActiveBlocksPerMultiprocessor(&per_cu, (const void*)fwd_megakernel, 512, LDS_BYTES) != hipSuccess || per_cu < 1) { fprintf(stderr, "kernel_launch: occupancy query gives %d blocks per CU\n", per_cu); per_cu = 1; }
        (void)hipGetLastError();
        grid = cus * 1;
        fprintf(stderr, "kernel_launch: grid %d (cus %d, per_cu %d)\n", grid, cus, per_cu);
    }
    if (grid < 0) return;
    if (hipMemsetAsync((char*)d_ws + WS_BAR, 0, BAR_BYTES, stream) != hipSuccess) { fprintf(stderr, "kernel_launch: hipMemsetAsync failed\n"); return; }
    Args a{};
    for (int i = 0; i < 23; ++i) a.in[i] = (const float*)d_in[i];
    a.out = (float*)d_out; a.ws = (unsigned char*)d_ws;
#if MK_N_LAUNCHES == 1
    a.ph_lo = 0; a.ph_hi = NPH;
    void* kargs[] = {&a};
    hipError_t e = hipLaunchCooperativeKernel((const void*)fwd_megakernel, dim3(grid), dim3(512), kargs, LDS_BYTES, stream);
    if (e != hipSuccess) fprintf(stderr, "kernel_launch: cooperative launch failed: %s (grid %d)\n", hipGetErrorString(e), grid);
#else
    for (int p = 0; p < NPH; ++p) {
        a.ph_lo = p; a.ph_hi = p + 1;
        hipLaunchKernelGGL(fwd_megakernel, dim3(grid), dim3(512), LDS_BYTES, stream, a);
    }
#endif
}
```

```cpp
#include <hip/hip_runtime.h>
#include <hip/hip_cooperative_groups.h>
#include <cstdio>
#include <cstdint>
namespace cg = cooperative_groups;

#define LAS __attribute__((address_space(3)))
typedef unsigned short bf16_t;
typedef short bf16x8 __attribute__((ext_vector_type(8)));
typedef float f32x4 __attribute__((ext_vector_type(4)));
typedef float f32x2 __attribute__((ext_vector_type(2)));
typedef unsigned u32x4 __attribute__((ext_vector_type(4)));
typedef unsigned u32x2 __attribute__((ext_vector_type(2)));

#ifndef MK_N_LAUNCHES
#define MK_N_LAUNCHES 1
#endif

constexpr int BATCH = 2, SEQ = 4096, D = 2048, M = BATCH * SEQ, FF = 5632, WC = 1024, WP = 1024, NIN = 7168, NADA = 18432, CONVK = 31;
constexpr float EPS = 1e-6f;
constexpr int NPH = 13;
constexpr int ADA_KC = 16, ADA_CC = NADA / 256, ADA_ITEMS = ADA_KC * ADA_CC;
constexpr int T_1IN = (D / 64) * (2 * FF / 64), T_1OUT = (FF / 64) * (D / 64), T_IN = (D / 64) * (NIN / 64), T_AOUT = (WC / 64) * (D / 64), T_B = (256 / 64) * (512 / 64), T_OUT = (D / 64) * (D / 64);
constexpr int NT = 2 * T_1IN + 2 * T_1OUT + T_IN + T_AOUT + 4 * T_B + T_OUT;
constexpr int CV_A_LO = 0, CV_A_HI = T_1IN, CV_B_LO = CV_A_HI, CV_B_HI = T_1IN + T_1OUT + T_IN + T_AOUT + 4 * T_B + T_OUT, CV_C_LO = CV_B_HI, CV_C_HI = NT;

constexpr size_t MiB = 1u << 20;
constexpr size_t WS_PART = 0, WS_ADA = 3 * MiB, WS_BAR = 3 * MiB + 512 * 1024, BAR_BYTES = 16384;
static_assert((size_t)16 * 2 * 18432 * 4 <= WS_ADA, "ada partials overlap");
constexpr size_t WS_W1IN = 4 * MiB, WS_W1OUT = 48 * MiB, WS_WIN = 70 * MiB, WS_WAOUT = 98 * MiB, WS_WB = 102 * MiB, WS_WOUT = 103 * MiB, WS_W2IN = 111 * MiB, WS_W2OUT = 155 * MiB;
constexpr size_t WS_XN = 178 * MiB, WS_ACT = 210 * MiB, WS_GLU = 298 * MiB, WS_POOLIN = 314 * MiB, WS_GATEA = 330 * MiB, WS_GATEB = 362 * MiB;
constexpr size_t WS_AACT = 394 * MiB, WS_MIXED = 410 * MiB, WS_MIXM = 426 * MiB, WS_TMP = 458 * MiB, WS_END = 490 * MiB;

constexpr int LDS_BYTES = 147456;

__device__ __forceinline__ unsigned cvt_pk_bf16(float lo, float hi) { unsigned r; asm volatile("v_cvt_pk_bf16_f32 %0, %1, %2" : "=v"(r) : "v"(lo), "v"(hi)); return r; }
__device__ __forceinline__ float bf_lo(unsigned u) { return __uint_as_float(u << 16); }
__device__ __forceinline__ float bf_hi(unsigned u) { return __uint_as_float(u & 0xffff0000u); }
__device__ __forceinline__ float sigm(float x) { return __builtin_amdgcn_rcpf(1.0f + __expf(-x)); }
__device__ __forceinline__ float wave_sum(float v) {
#pragma unroll
    for (int o = 1; o < 64; o <<= 1) v += __shfl_xor(v, o);
    return v;
}

namespace pg8 {
constexpr int BM = 256, BK = 64, HALF = 128, HTB = HALF * BK * 2, STAGE_BYTES = 8 * HTB, NXCD = 8, WGM = 8;

__host__ __device__ __forceinline__ int lds_byte(int r, int c) { const int st = (r >> 4) * 2 + (c >> 5), rr = r & 15, cc = c & 31, ob = rr * 64 + cc * 2; return st * 1024 + (ob ^ (((ob >> 9) & 1) << 5)); }
__host__ __device__ __forceinline__ void stage_rc(int b, int& R, int& C) { const int st = b / 1024, sb = b % 1024, swz = sb ^ (((sb >> 9) & 1) << 5); R = (st >> 1) * 16 + swz / 64; C = (st & 1) * 32 + (swz % 64) / 2; }
__host__ __device__ __forceinline__ int perm32(int rho) { const int n = rho >> 4, i = rho & 15; return 8 * (i >> 2) + 4 * n + (i & 3); }

struct Unit { int pm, pn; };
struct Gemm { const bf16_t* A; const bf16_t* Bt; int M, N, K, lda, ldb, agshift, agbytes; };

struct StaticOrder {
    int nM, nN, nwg, G, c;
    __host__ __device__ void init(int M_, int N_, int G_, int c_) { nM = M_ / BM; nN = N_ / BM; nwg = nM * nN; G = G_; c = c_; }
    __host__ __device__ bool next(int i, Unit& u) const {
        const long L = (long)i * G + c; if (L >= nwg) return false;
        int wgid = (int)L; { const int q = nwg / NXCD, r = nwg % NXCD, xcd = wgid % NXCD, off = wgid / NXCD; wgid = (xcd < r ? xcd * (q + 1) : r * (q + 1) + (xcd - r) * q) + off; }
        const int nig = WGM * nN, gid = wgid / nig, fm = gid * WGM, gsz = (nM - fm) < WGM ? (nM - fm) : WGM;
        u.pm = fm + ((wgid % nig) % gsz); u.pn = (wgid % nig) / gsz; return true;
    }
};


template <int MODE>
__device__ __forceinline__ void pair_store(const f32x4 (&acc)[2][2][4][2], const Unit& u, int wr, int wc, int fr, int fq, bf16_t* O, int ldc, int ct) {
    const int row0 = u.pm * BM + wr * 64 + fr, col0 = ct * 128 + wc * 32 + 8 * fq;
#pragma unroll
    for (int ai = 0; ai < 2; ++ai)
#pragma unroll
        for (int m = 0; m < 4; ++m) {
            bf16_t* rowp = O + (size_t)(row0 + ai * HALF + m * 16) * ldc + col0;
            float o[8];
#pragma unroll
            for (int n = 0; n < 2; ++n)
#pragma unroll
                for (int e = 0; e < 4; ++e) { const float p = acc[ai][0][m][n][e], q = acc[ai][1][m][n][e]; o[n * 4 + e] = (MODE == 0) ? p * sigm(p) * q : p * sigm(q); }
            u32x4 w; w.x = cvt_pk_bf16(o[0], o[1]); w.y = cvt_pk_bf16(o[2], o[3]); w.z = cvt_pk_bf16(o[4], o[5]); w.w = cvt_pk_bf16(o[6], o[7]);
            *(u32x4*)rowp = w;
        }
}
template <int ACT>
__device__ __forceinline__ void tile_store(const f32x4 (&acc)[2][2][4][2], const Unit& u, int wr, int wc, int fr, int fq, bf16_t* O, int ldc, int colt) {
    const int row0 = u.pm * BM + wr * 64 + fr, col0 = colt + wc * 32 + 8 * fq;
#pragma unroll
    for (int ai = 0; ai < 2; ++ai)
#pragma unroll
        for (int m = 0; m < 4; ++m) {
            bf16_t* rowp = O + (size_t)(row0 + ai * HALF + m * 16) * ldc + col0;
#pragma unroll
            for (int bj = 0; bj < 2; ++bj) {
                f32x4 v0 = acc[ai][bj][m][0], v1 = acc[ai][bj][m][1];
                if (ACT == 1) {
#pragma unroll
                    for (int e = 0; e < 4; ++e) { v0[e] = sigm(v0[e]); v1[e] = sigm(v1[e]); }
                }
                u32x4 w; w.x = cvt_pk_bf16(v0[0], v0[1]); w.y = cvt_pk_bf16(v0[2], v0[3]); w.z = cvt_pk_bf16(v1[0], v1[1]); w.w = cvt_pk_bf16(v1[2], v1[3]);
                *(u32x4*)(rowp + bj * HALF) = w;
            }
        }
}

struct EpiSwiGLU {
    static constexpr bool PERM = true;
    bf16_t* O;
    __device__ __forceinline__ void operator()(const f32x4 (&acc)[2][2][4][2], const Unit& u, int wr, int wc, int fr, int fq) const { pair_store<0>(acc, u, wr, wc, fr, fq, O, FF, u.pn); }
};
struct EpiMixIn {
    static constexpr bool PERM = true;
    bf16_t *glu, *poolin, *gatea, *gateb;
    __device__ __forceinline__ void operator()(const f32x4 (&acc)[2][2][4][2], const Unit& u, int wr, int wc, int fr, int fq) const {
        if (u.pn < 8) pair_store<1>(acc, u, wr, wc, fr, fq, glu, WC, u.pn);
        else if (u.pn < 12) tile_store<0>(acc, u, wr, wc, fr, fq, poolin, WP, (u.pn - 8) * BM);
        else if (u.pn < 20) tile_store<0>(acc, u, wr, wc, fr, fq, gatea, D, (u.pn - 12) * BM);
        else tile_store<0>(acc, u, wr, wc, fr, fq, gateb, D, (u.pn - 20) * BM);
    }
};
struct EpiResid {
    static constexpr bool PERM = false;
    const float* base; float* out; const float* gate; float s;
    __device__ __forceinline__ void operator()(const f32x4 (&acc)[2][2][4][2], const Unit& u, int wr, int wc, int fr, int fq) const {
        const int b = u.pm >> 4, col0 = u.pn * BM + wc * 32 + 4 * fq;
        const float* gp = gate + (size_t)b * NADA + col0;
        f32x4 gv[2][2];
#pragma unroll
        for (int bj = 0; bj < 2; ++bj)
#pragma unroll
            for (int n = 0; n < 2; ++n) gv[bj][n] = *(const f32x4*)(gp + bj * HALF + n * 16) * s;
#pragma unroll
        for (int ai = 0; ai < 2; ++ai)
#pragma unroll
            for (int m = 0; m < 4; ++m) {
                const size_t off = (size_t)(u.pm * BM + ai * HALF + wr * 64 + m * 16 + fr) * D + col0;
#pragma unroll
                for (int bj = 0; bj < 2; ++bj)
#pragma unroll
                    for (int n = 0; n < 2; ++n) { const f32x4 bs = *(const f32x4*)(base + off + bj * HALF + n * 16); *(f32x4*)(out + off + bj * HALF + n * 16) = bs + gv[bj][n] * acc[ai][bj][m][n]; }
                if (m & 1) asm volatile("" ::: "memory");
            }
    }
};
template <bool FIRST>
struct EpiMixOut {
    static constexpr bool PERM = true;
    const bf16_t* gatev; const float* bias; const float* ls; const bf16_t* tmp_in; bf16_t* O;
    __device__ __forceinline__ void operator()(const f32x4 (&acc)[2][2][4][2], const Unit& u, int wr, int wc, int fr, int fq) const {
        const int row0 = u.pm * BM + wr * 64 + fr, col0 = u.pn * BM + wc * 32 + 8 * fq;
#pragma unroll
        for (int ai = 0; ai < 2; ++ai)
#pragma unroll
            for (int m = 0; m < 4; ++m) {
                const size_t off = (size_t)(row0 + ai * HALF + m * 16) * D + col0;
#pragma unroll
                for (int bj = 0; bj < 2; ++bj) {
                    const u32x4 gw = *(const u32x4*)(gatev + off + bj * HALF);
                    const f32x4 b0 = *(const f32x4*)(bias + col0 + bj * HALF), b1 = *(const f32x4*)(bias + col0 + bj * HALF + 4);
                    f32x4 v0 = acc[ai][bj][m][0] + b0, v1 = acc[ai][bj][m][1] + b1;
                    const f32x4 g0 = (f32x4){sigm(bf_lo(gw.x)), sigm(bf_hi(gw.x)), sigm(bf_lo(gw.y)), sigm(bf_hi(gw.y))}, g1 = (f32x4){sigm(bf_lo(gw.z)), sigm(bf_hi(gw.z)), sigm(bf_lo(gw.w)), sigm(bf_hi(gw.w))};
                    if (FIRST) { const f32x4 l0 = *(const f32x4*)(ls + col0 + bj * HALF), l1 = *(const f32x4*)(ls + col0 + bj * HALF + 4); v0 = v0 * l0 * g0; v1 = v1 * l1 * g1; }
                    else {
                        const u32x4 tw = *(const u32x4*)(tmp_in + off + bj * HALF);
                        v0 = v0 * g0 + (f32x4){bf_lo(tw.x), bf_hi(tw.x), bf_lo(tw.y), bf_hi(tw.y)};
                        v1 = v1 * g1 + (f32x4){bf_lo(tw.z), bf_hi(tw.z), bf_lo(tw.w), bf_hi(tw.w)};
                    }
                    u32x4 w; w.x = cvt_pk_bf16(v0[0], v0[1]); w.y = cvt_pk_bf16(v0[2], v0[3]); w.z = cvt_pk_bf16(v1[0], v1[1]); w.w = cvt_pk_bf16(v1[2], v1[3]);
                    *(u32x4*)(O + off + bj * HALF) = w;
                }
                asm volatile("" ::: "memory");
            }
    }
};

template <class Epi>
__device__ __forceinline__ void gemm_phase(LAS unsigned char* lds, const Gemm g, const StaticOrder& S, const Epi& E) {
    const int tid = threadIdx.x, wid = __builtin_amdgcn_readfirstlane(tid >> 6), lane = tid & 63, wr = wid >> 2, wc = wid & 3, fr = lane & 15, fq = lane >> 4;
    const int K = g.K, nt = K / BK;
    unsigned voffA[2], voffB[2];
#pragma unroll
    for (int i = 0; i < 2; ++i) { int R, C; stage_rc(tid * 16 + i * 8192, R, C); const int Rb = Epi::PERM ? ((R & ~31) + perm32(R & 31)) : R;
        voffA[i] = (unsigned)(R * g.lda + C) * 2u; voffB[i] = (unsigned)(Rb * g.ldb + C) * 2u; }
    const size_t kstep = (size_t)(BK * 2);
    const size_t hstepA = (size_t)HALF * g.lda * 2, hstepB = (size_t)HALF * g.ldb * 2;
    const size_t tstepA = 2 * hstepA, tstepB = 2 * hstepB;
    const unsigned ldsw = (unsigned)wid * 1024u;
    const int aoff = lds_byte(wr * 64 + fr, fq * 8), boff = lds_byte(wc * 32 + fr, fq * 8);
#define PG8_SA(b, h) (((b) * 2 + (h)) * HTB)
#define PG8_SB(b, h) ((4 + (b) * 2 + (h)) * HTB)
#define PG8_STAGE(bufoff, gbase, voff) do { _Pragma("unroll") for (int _i = 0; _i < 2; ++_i) \
        __builtin_amdgcn_global_load_lds((const unsigned*)((const char*)(gbase) + (voff)[_i]), (LAS unsigned*)(lds + (bufoff) + ldsw + _i * 8192), 16, 0, 0); } while (0)
#define PG8_LDA(dst, b, h) do { _Pragma("unroll") for (int m = 0; m < 4; ++m) _Pragma("unroll") for (int k = 0; k < 2; ++k) dst[m][k] = *(const LAS bf16x8*)(lds + PG8_SA(b, h) + aoff + m * 2048 + k * 1024); } while (0)
#define PG8_LDB(dst, b, h) do { _Pragma("unroll") for (int n = 0; n < 2; ++n) _Pragma("unroll") for (int k = 0; k < 2; ++k) dst[n][k] = *(const LAS bf16x8*)(lds + PG8_SB(b, h) + boff + n * 2048 + k * 1024); } while (0)
#define PG8_MMA(ai, bj, At, Bt) do { __builtin_amdgcn_s_setprio(1); _Pragma("unroll") for (int m = 0; m < 4; ++m) _Pragma("unroll") for (int n = 0; n < 2; ++n) _Pragma("unroll") for (int k = 0; k < 2; ++k) \
        acc[ai][bj][m][n] = __builtin_amdgcn_mfma_f32_16x16x32_bf16(Bt[n][k], At[m][k], acc[ai][bj][m][n], 0, 0, 0); __builtin_amdgcn_s_setprio(0); } while (0)
#define PG8_WAIT_V(n) asm volatile("s_waitcnt vmcnt(" #n ")" ::: "memory")
#define PG8_WAIT_L(n) asm volatile("s_waitcnt lgkmcnt(" #n ")" ::: "memory")
#define PG8_BAR __builtin_amdgcn_s_barrier()
#define PG8_SCHED __builtin_amdgcn_sched_barrier(0)
    Unit cur, nxt; int ui = 0;
    if (!S.next(0, cur)) return;
    f32x4 acc[2][2][4][2];
#pragma unroll
    for (int a = 0; a < 2; ++a)
#pragma unroll
        for (int b = 0; b < 2; ++b)
#pragma unroll
            for (int m = 0; m < 4; ++m)
#pragma unroll
                for (int n = 0; n < 2; ++n) acc[a][b][m][n] = (f32x4){0.f, 0.f, 0.f, 0.f};
    bf16x8 At[4][2], B0[2][2], B1[2][2];
    const char* cA = (const char*)g.A + (size_t)cur.pm * tstepA + (size_t)(cur.pn >> g.agshift) * g.agbytes; const char* cB = (const char*)g.Bt + (size_t)cur.pn * tstepB;
    PG8_STAGE(PG8_SB(0, 0), cB, voffB); PG8_STAGE(PG8_SB(0, 1), cB + hstepB, voffB); PG8_STAGE(PG8_SA(0, 0), cA, voffA); PG8_STAGE(PG8_SA(0, 1), cA + hstepA, voffA);
    if (wr == 1) PG8_BAR;
    PG8_WAIT_V(2); PG8_BAR;
    PG8_STAGE(PG8_SB(1, 0), cB + kstep, voffB); PG8_STAGE(PG8_SA(1, 0), cA + kstep, voffA); PG8_STAGE(PG8_SB(1, 1), cB + hstepB + kstep, voffB);
    PG8_WAIT_V(6); PG8_BAR;
    for (;;) {
        const bool has_next = S.next(ui + 1, nxt);
        const char* nA = has_next ? (const char*)g.A + (size_t)nxt.pm * tstepA + (size_t)(nxt.pn >> g.agshift) * g.agbytes : cA; const char* nB = has_next ? (const char*)g.Bt + (size_t)nxt.pn * tstepB : cB;
#pragma unroll 1
        for (int t = 0; t < nt; t += 2) {
            const bool last = (t == nt - 2);
            const char* a1 = cA + (size_t)(t + 1) * kstep;
            const char* a2 = last ? nA : cA + (size_t)(t + 2) * kstep; const char* b2 = last ? nB : cB + (size_t)(t + 2) * kstep;
            const char* a3 = a2 + kstep; const char* b3 = b2 + kstep;
            PG8_LDB(B0, 0, 0); PG8_LDB(B1, 0, 1); PG8_SCHED; PG8_LDA(At, 0, 0); PG8_STAGE(PG8_SA(1, 1), a1 + hstepA, voffA);
            PG8_WAIT_V(8); PG8_WAIT_L(0); PG8_BAR; PG8_MMA(0, 0, At, B0); PG8_MMA(0, 1, At, B1); PG8_BAR; PG8_SCHED;
            PG8_LDA(At, 0, 1); PG8_STAGE(PG8_SB(0, 0), b2, voffB); PG8_STAGE(PG8_SB(0, 1), b2 + hstepB, voffB); PG8_STAGE(PG8_SA(0, 0), a2, voffA);
            PG8_WAIT_V(8); PG8_WAIT_L(0); PG8_BAR; PG8_MMA(1, 0, At, B0); PG8_MMA(1, 1, At, B1); PG8_BAR; PG8_SCHED;
            PG8_LDB(B0, 1, 0); PG8_LDB(B1, 1, 1); PG8_SCHED; PG8_LDA(At, 1, 0); PG8_STAGE(PG8_SA(0, 1), a2 + hstepA, voffA);
            PG8_WAIT_V(8); PG8_WAIT_L(0); PG8_BAR; PG8_MMA(0, 0, At, B0); PG8_MMA(0, 1, At, B1); PG8_BAR; PG8_SCHED;
            PG8_LDA(At, 1, 1); PG8_STAGE(PG8_SB(1, 0), b3, voffB); PG8_STAGE(PG8_SB(1, 1), b3 + hstepB, voffB); PG8_STAGE(PG8_SA(1, 0), a3, voffA);
            PG8_WAIT_V(8); PG8_WAIT_L(0); PG8_BAR; PG8_MMA(1, 0, At, B0); PG8_MMA(1, 1, At, B1); PG8_BAR; PG8_SCHED;
        }
        if (wr == 0) PG8_BAR;
        asm volatile("" ::: "memory");
        E(acc, cur, wr, wc, fr, fq);
        asm volatile("" ::: "memory");
        if (!has_next) break;
#pragma unroll
        for (int a = 0; a < 2; ++a)
#pragma unroll
            for (int b = 0; b < 2; ++b)
#pragma unroll
                for (int m = 0; m < 4; ++m)
#pragma unroll
                    for (int n = 0; n < 2; ++n) acc[a][b][m][n] = (f32x4){0.f, 0.f, 0.f, 0.f};
        cur = nxt; cA = nA; cB = nB; ++ui;
        if (wr == 1) PG8_BAR;
    }
    PG8_WAIT_V(0);
    PG8_BAR;
#undef PG8_SA
#undef PG8_SB
#undef PG8_STAGE
#undef PG8_LDA
#undef PG8_LDB
#undef PG8_MMA
#undef PG8_WAIT_V
#undef PG8_WAIT_L
#undef PG8_BAR
#undef PG8_SCHED
}
}

__device__ __forceinline__ void tr_tile(const float* __restrict__ W, int N, int k0, int n0, bf16_t* __restrict__ WT, int ldk, int drow0, LAS unsigned* scr, int lane) {
    const int l16 = lane & 15, lq = lane >> 4;
    f32x4 v[16];
#pragma unroll
    for (int i = 0; i < 16; ++i) { const int kk = 8 * (i >> 1) + 2 * lq + (i & 1); v[i] = __builtin_nontemporal_load((const f32x4*)(W + (size_t)(k0 + kk) * N + n0 + 4 * l16)); }
#pragma unroll
    for (int p = 0; p < 8; ++p) {
        const f32x4 a = v[2 * p], b = v[2 * p + 1];
        const int chunk = (p ^ (l16 & 7)) * 4 + lq;
#pragma unroll
        for (int j = 0; j < 4; ++j) scr[(4 * l16 + j) * 32 + chunk] = cvt_pk_bf16(a[j], b[j]);
    }
    asm volatile("s_waitcnt lgkmcnt(0)" ::: "memory");
#pragma unroll
    for (int jj = 0; jj < 8; ++jj) {
        const int n = (lane >> 3) + 8 * jj, c = lane & 7;
        const u32x4 o = *(const LAS u32x4*)(scr + n * 32 + ((c ^ ((n >> 2) & 7)) * 4));
        *(u32x4*)(WT + (size_t)(drow0 + n) * ldk + k0 + 8 * c) = o;
    }
    asm volatile("s_waitcnt lgkmcnt(0)" ::: "memory");
}
__device__ __forceinline__ void tr_item(const float* W, int K, int N, bf16_t* WT, int ph, int r, LAS unsigned* scr, int lane) {
    const int nblk = N >> 6, kb = r / nblk, nb = r - kb * nblk, n0 = nb << 6;
    int drow0 = n0;
    if (n0 < 2 * ph) { const int second = n0 >= ph, j = n0 - (second ? ph : 0); drow0 = 256 * (j >> 7) + 128 * second + (j & 127); }
    tr_tile(W, N, kb << 6, n0, WT, K, drow0, scr, lane);
}
__device__ __forceinline__ void ada_item(const float* __restrict__ c, const float* __restrict__ w_ada, float* __restrict__ part, int item, int lane) {
    const int kc = item / ADA_CC, cc = item - kc * ADA_CC, k0 = kc * 128, col = cc * 256 + 4 * lane;
    float s0[2], s1[2];
#pragma unroll
    for (int q = 0; q < 2; ++q) { const float a = c[k0 + 64 * q + lane], b = c[D + k0 + 64 * q + lane]; s0[q] = a * sigm(a); s1[q] = b * sigm(b); }
    f32x4 acc0 = {0.f, 0.f, 0.f, 0.f}, acc1 = {0.f, 0.f, 0.f, 0.f};
    const float* wp = w_ada + (size_t)k0 * NADA + col;
#pragma unroll
    for (int q = 0; q < 2; ++q) {
        for (int l0 = 0; l0 < 64; l0 += 16) {
            f32x4 w[16];
#pragma unroll
            for (int i = 0; i < 16; ++i) w[i] = __builtin_nontemporal_load((const f32x4*)(wp + (size_t)(64 * q + l0 + i) * NADA));
#pragma unroll
            for (int i = 0; i < 16; ++i) {
                const float a = __uint_as_float(__builtin_amdgcn_readlane(__float_as_uint(s0[q]), l0 + i)), b = __uint_as_float(__builtin_amdgcn_readlane(__float_as_uint(s1[q]), l0 + i));
                acc0 += w[i] * a; acc1 += w[i] * b;
            }
        }
    }
    *(f32x4*)(part + (size_t)(kc * 2 + 0) * NADA + col) = acc0;
    *(f32x4*)(part + (size_t)(kc * 2 + 1) * NADA + col) = acc1;
}

struct Args { const float* in[23]; float* out; unsigned char* ws; int ph_lo, ph_hi, dump_sel, pad; };
typedef const __attribute__((address_space(4))) Args* KArgs;
__device__ __forceinline__ KArgs kargs() { KArgs p = (KArgs)__builtin_amdgcn_kernarg_segment_ptr(); asm volatile("" : "+s"(p)); return p; }

__device__ __forceinline__ void convert_tiles(LAS unsigned char* lds, int wave, int lane, int first, int stride, int lo, int hi) {
    const KArgs ka = kargs();
    unsigned char* ws = ka->ws;
    LAS unsigned* scr = (LAS unsigned*)(lds + wave * 16384);
    for (int it = lo + first; it < hi; it += stride) {
        int r = it;
        if (r < T_1IN) { tr_item(ka->in[5], D, 2 * FF, (bf16_t*)(ws + WS_W1IN), FF, r, scr, lane); continue; } r -= T_1IN;
        if (r < T_1OUT) { tr_item(ka->in[6], FF, D, (bf16_t*)(ws + WS_W1OUT), 0, r, scr, lane); continue; } r -= T_1OUT;
        if (r < T_IN) { tr_item(ka->in[8], D, NIN, (bf16_t*)(ws + WS_WIN), WC, r, scr, lane); continue; } r -= T_IN;
        if (r < T_AOUT) { tr_item(ka->in[13], WC, D, (bf16_t*)(ws + WS_WAOUT), 0, r, scr, lane); continue; } r -= T_AOUT;
        if (r < 4 * T_B) { const int grp = r / T_B; tr_item(ka->in[15] + (size_t)grp * 256 * 512, 256, 512, (bf16_t*)(ws + WS_WB) + (size_t)grp * 512 * 256, 0, r - grp * T_B, scr, lane); continue; } r -= 4 * T_B;
        if (r < T_OUT) { tr_item(ka->in[18], D, D, (bf16_t*)(ws + WS_WOUT), 0, r, scr, lane); continue; } r -= T_OUT;
        if (r < T_1IN) { tr_item(ka->in[20], D, 2 * FF, (bf16_t*)(ws + WS_W2IN), FF, r, scr, lane); continue; } r -= T_1IN;
        tr_item(ka->in[21], FF, D, (bf16_t*)(ws + WS_W2OUT), 0, r, scr, lane);
    }
}
__device__ __forceinline__ void convert_in_tail(LAS unsigned char* lds, int wave, int lane, int nwg, int lo, int hi) {
    const int G = gridDim.x, rem = nwg % G, id = (int)blockIdx.x - rem;
    if (id >= 0) convert_tiles(lds, wave, lane, id * 8 + wave, (G - rem) * 8, lo, hi);
}
__device__ __forceinline__ void prologue_phase(LAS unsigned char* lds, int wave, int lane) {
    const int gw = blockIdx.x * 8 + wave, NGW = gridDim.x * 8;
    if (NGW > ADA_ITEMS) {
        if (gw < ADA_ITEMS) { const KArgs ka = kargs(); ada_item(ka->in[1], ka->in[2], (float*)(ka->ws + WS_PART), gw, lane); return; }
        convert_tiles(lds, wave, lane, gw - ADA_ITEMS, NGW - ADA_ITEMS, CV_A_LO, CV_A_HI);
    } else {
        const KArgs ka = kargs();
        for (int it = gw; it < ADA_ITEMS; it += NGW) ada_item(ka->in[1], ka->in[2], (float*)(ka->ws + WS_PART), it, lane);
        convert_tiles(lds, wave, lane, gw, NGW, CV_A_LO, CV_A_HI);
    }
}

__device__ __forceinline__ void norm_phase(LAS float* ldsf, const float* __restrict__ src, bf16_t* __restrict__ XN, const float* __restrict__ g, float* ada, int sub, const float* __restrict__ part, const float* __restrict__ b_ada, int tid, int wave, int lane) {
    if (part) {
        for (int idx = blockIdx.x * 512 + tid; idx < BATCH * NADA; idx += gridDim.x * 512) {
            const int b = idx / NADA, j = idx - b * NADA; float s = b_ada[j];
#pragma unroll
            for (int p = 0; p < ADA_KC; ++p) s += part[(size_t)(p * 2 + b) * NADA + j];
            ada[idx] = s;
        }
    }
    for (int rb = blockIdx.x; rb < M / 32; rb += gridDim.x) {
        const int b = rb / (SEQ / 32);
        for (int c = tid; c < D; c += 512) {
            const int jsh = sub * 6144 + c, jsc = jsh + D; float sh, sc;
            if (part) { sh = b_ada[jsh]; sc = b_ada[jsc];
#pragma unroll
                for (int p = 0; p < ADA_KC; ++p) { sh += part[(size_t)(p * 2 + b) * NADA + jsh]; sc += part[(size_t)(p * 2 + b) * NADA + jsc]; } }
            else { sh = ada[(size_t)b * NADA + jsh]; sc = ada[(size_t)b * NADA + jsc]; }
            ldsf[c] = g[c] * (1.0f + sc); ldsf[D + c] = sh;
        }
        __syncthreads();
#pragma unroll 1
        for (int i = 0; i < 4; ++i) {
            const int row = rb * 32 + wave * 4 + i;
            const f32x4* xr = (const f32x4*)(src + (size_t)row * D) + lane;
            f32x4 v[8]; float ss = 0.f;
#pragma unroll
            for (int j = 0; j < 8; ++j) { v[j] = xr[64 * j]; ss += (v[j].x * v[j].x + v[j].y * v[j].y) + (v[j].z * v[j].z + v[j].w * v[j].w); }
            const float rstd = rsqrtf(wave_sum(ss) * (1.0f / D) + EPS);
            u32x2* o8 = (u32x2*)(XN + (size_t)row * D) + lane;
#pragma unroll
            for (int j = 0; j < 8; ++j) {
                const f32x4 av = *(const LAS f32x4*)(ldsf + 4 * lane + 256 * j), sv = *(const LAS f32x4*)(ldsf + D + 4 * lane + 256 * j);
                const f32x4 o = v[j] * rstd * av + sv;
                u32x2 w; w.x = cvt_pk_bf16(o.x, o.y); w.y = cvt_pk_bf16(o.z, o.w); o8[64 * j] = w;
            }
        }
        __syncthreads();
    }
}
__device__ __forceinline__ void final_norm_phase(float* io, const float* __restrict__ g, int wave, int lane) {
    for (int row = blockIdx.x * 8 + wave; row < M; row += gridDim.x * 8) {
        f32x4* xr = (f32x4*)(io + (size_t)row * D) + lane;
        f32x4 v[8]; float ss = 0.f;
#pragma unroll
        for (int j = 0; j < 8; ++j) { v[j] = xr[64 * j]; ss += (v[j].x * v[j].x + v[j].y * v[j].y) + (v[j].z * v[j].z + v[j].w * v[j].w); }
        const float rstd = rsqrtf(wave_sum(ss) * (1.0f / D) + EPS);
#pragma unroll
        for (int j = 0; j < 8; ++j) { const f32x4 gv = *((const f32x4*)g + lane + 64 * j); xr[64 * j] = v[j] * rstd * gv; }
    }
}

__device__ __forceinline__ void convpool_phase(LAS float* ldsf, const bf16_t* __restrict__ GLU, const bf16_t* __restrict__ POOLIN, const float* __restrict__ conv_w, const float* __restrict__ conv_b,
                                               const float* __restrict__ ln_g, const float* __restrict__ ln_b, bf16_t* __restrict__ AACT, bf16_t* __restrict__ MIXED, int tid, int wave, int lane) {
    const int c0 = 2 * tid;
    LAS float* red = ldsf;
    LAS float* stat = ldsf + 256;
    for (int ch = blockIdx.x; ch < M / 16; ch += gridDim.x) {
        const int t0 = ch * 16, tb = t0 & ~(SEQ - 1);
        {
            float w0[CONVK], w1[CONVK];
#pragma unroll
            for (int j = 0; j < CONVK; ++j) { const f32x2 w = *(const f32x2*)(conv_w + j * WC + c0); w0[j] = w.x; w1[j] = w.y; }
            unsigned rows[46];
#pragma unroll
            for (int r = 0; r < 46; ++r) { const int t = t0 - 30 + r; rows[r] = (t >= tb) ? *(const unsigned*)(GLU + (size_t)t * WC + c0) : 0u; }
            const f32x2 cb = *(const f32x2*)(conv_b + c0);
            float o0[16], o1[16];
#pragma unroll
            for (int i = 0; i < 16; ++i) {
                float a0 = cb.x, a1 = cb.y;
#pragma unroll
                for (int j = 0; j < CONVK; ++j) { a0 += bf_lo(rows[i + j]) * w0[j]; a1 += bf_hi(rows[i + j]) * w1[j]; }
                o0[i] = a0; o1[i] = a1;
                const float s = wave_sum(a0 + a1), q = wave_sum(a0 * a0 + a1 * a1);
                if (lane == 0) { red[(i * 8 + wave) * 2] = s; red[(i * 8 + wave) * 2 + 1] = q; }
            }
            __syncthreads();
            if (tid < 16) {
                float s = 0.f, q = 0.f;
#pragma unroll
                for (int w = 0; w < 8; ++w) { s += red[(tid * 8 + w) * 2]; q += red[(tid * 8 + w) * 2 + 1]; }
                const float mean = s * (1.0f / WC), var = fmaxf(q * (1.0f / WC) - mean * mean, 0.f);
                stat[tid * 2] = mean; stat[tid * 2 + 1] = rsqrtf(var + EPS);
            }
            __syncthreads();
            const f32x2 lg = *(const f32x2*)(ln_g + c0), lb = *(const f32x2*)(ln_b + c0);
#pragma unroll
            for (int i = 0; i < 16; ++i) {
                const float mean = stat[i * 2], rstd = stat[i * 2 + 1];
                float y0 = (o0[i] - mean) * rstd * lg.x + lb.x, y1 = (o1[i] - mean) * rstd * lg.y + lb.y;
                y0 = y0 * sigm(y0); y1 = y1 * sigm(y1);
                *(unsigned*)(AACT + (size_t)(t0 + i) * WC + c0) = cvt_pk_bf16(y0, y1);
            }
        }
        {
            const int grp = c0 >> 8; const float wf = (float)(2 << grp);
            unsigned rows[31];
#pragma unroll
            for (int r = 0; r < 31; ++r) { const int t = t0 - 15 + r; rows[r] = (t >= tb) ? *(const unsigned*)(POOLIN + (size_t)t * WP + c0) : 0u; }
#pragma unroll
            for (int i = 0; i < 16; ++i) {
                const int r = 15 + i;
                float a0 = 0.f, a1 = 0.f, s0 = 0.f, s1 = 0.f;
#pragma unroll
                for (int d = 0; d < 16; ++d) {
                    a0 += bf_lo(rows[r - d]); a1 += bf_hi(rows[r - d]);
                    if (d == 1) { if (grp == 0) { s0 = a0; s1 = a1; } }
                    if (d == 3) { if (grp == 1) { s0 = a0; s1 = a1; } }
                    if (d == 7) { if (grp == 2) { s0 = a0; s1 = a1; } }
                    if (d == 15) { if (grp == 3) { s0 = a0; s1 = a1; } }
                }
                const float cnt = fminf((float)(t0 + i - tb + 1), wf), inv = 1.0f / cnt;
                const float m0 = s0 * inv - bf_lo(rows[r]), m1 = s1 * inv - bf_hi(rows[r]);
                *(unsigned*)(MIXED + (size_t)(t0 + i) * WP + c0) = cvt_pk_bf16(m0, m1);
            }
        }
        __syncthreads();
    }
}

#define XB_TMO      128
#define XB_XCNT(j)  (256  + 64 * (j))
#define XB_XSUB(j)  (1280 + 64 * (j))
#define XB_XGEN(j)  (2304 + 64 * (j))
#define XB_TOP      3328
#define XB_TOPGEN   3392
#define XCD_BAR_WORDS 3456
#define XB_SPIN_CAP (1u << 18)
__device__ __forceinline__ unsigned xb_ld(unsigned* p)              { return __hip_atomic_load(p, __ATOMIC_RELAXED, __HIP_MEMORY_SCOPE_AGENT); }
__device__ __forceinline__ unsigned xb_add(unsigned* p, unsigned v) { return __hip_atomic_fetch_add(p, v, __ATOMIC_RELAXED, __HIP_MEMORY_SCOPE_AGENT); }
__device__ __forceinline__ unsigned xb_xcc_id() { return (unsigned)__builtin_amdgcn_s_getreg((3 << 11) | 20) & 0xFu; }
#define XB_SPIN(cond, bar) do { unsigned _sp = 0; while (cond) { __builtin_amdgcn_s_sleep(1); \
    if ((++_sp & 255u) == 0u) { if (xb_ld(&(bar)[XB_TMO])) break; if (_sp > XB_SPIN_CAP) { atomicAdd(&(bar)[XB_TMO], 1u); break; } } } } while (0)
struct XcdBarrier { unsigned* bar; unsigned x; volatile LAS unsigned* st; };
__device__ __forceinline__ XcdBarrier xcd_barrier_post(unsigned* bar, volatile LAS unsigned* st) {
    XcdBarrier b; b.bar = bar; b.x = xb_xcc_id(); b.st = st;
    if (threadIdx.x == 0) (void)xb_add(&bar[XB_XCNT(b.x)], 1u);
    return b;
}
__device__ __forceinline__ void xcd_barrier_complete(unsigned* bar, unsigned x, unsigned& nloc, unsigned& nx) {
    const unsigned G = gridDim.x * gridDim.y * gridDim.z;
    unsigned sum, cnt, mine, sp = 0u;
    for (;;) {
        sum = 0u; cnt = 0u; mine = 0u;
#pragma unroll
        for (unsigned j = 0; j < 16; ++j) { const unsigned c = xb_ld(&bar[XB_XCNT(j)]); sum += c; cnt += (c > 0u) ? 1u : 0u; mine = (j == x) ? c : mine; }
        if (sum == G) break;
        __builtin_amdgcn_s_sleep(1);
        if ((++sp & 255u) == 0u) { if (xb_ld(&bar[XB_TMO])) break; if (sp > XB_SPIN_CAP) { atomicAdd(&bar[XB_TMO], 1u); break; } }
    }
    nloc = mine > 0u ? mine : 1u; nx = cnt > 0u ? cnt : 1u;
}
__device__ __forceinline__ void xcd_barrier(const XcdBarrier& b) {
    asm volatile("s_waitcnt vmcnt(0)" ::: "memory");
    __syncthreads();
    if (threadIdx.x == 0) {
        unsigned* bar = b.bar;
        __builtin_amdgcn_s_waitcnt(0);
        unsigned nloc = b.st[0], nx = b.st[1];
        if (nloc == 0u) { xcd_barrier_complete(bar, b.x, nloc, nx); b.st[0] = nloc; b.st[1] = nx; }
        const unsigned old = xb_add(&bar[XB_XSUB(b.x)], 1u);
        const unsigned gen = old / nloc;
        if (old + 1u == (gen + 1u) * nloc) {
            __builtin_amdgcn_fence(__ATOMIC_RELEASE, "agent");
            asm volatile("s_waitcnt vmcnt(0)" ::: "memory");
            const unsigned og = xb_add(&bar[XB_TOP], 1u);
            const unsigned tg = og / nx;
            if (og + 1u == (tg + 1u) * nx) xb_add(&bar[XB_TOPGEN], 1u);
            else XB_SPIN(xb_ld(&bar[XB_TOPGEN]) == tg, bar);
            __builtin_amdgcn_fence(__ATOMIC_ACQUIRE, "agent");
            xb_add(&bar[XB_XGEN(b.x)], 1u);
            asm volatile("s_waitcnt vmcnt(0)" ::: "memory");
        } else {
            XB_SPIN(xb_ld(&bar[XB_XGEN(b.x)]) == gen, bar);
            __builtin_amdgcn_fence(__ATOMIC_ACQUIRE, "agent");
            asm volatile("s_waitcnt vmcnt(0)" ::: "memory");
        }
    }
    __syncthreads();
}

__global__ void __launch_bounds__(512, 2) fwd_megakernel(Args args) {
    extern __shared__ __attribute__((aligned(16))) unsigned char lds_raw[];
    LAS unsigned char* lds = (LAS unsigned char*)lds_raw;
    cg::grid_group grid = cg::this_grid();
    const int tid = threadIdx.x, lane = tid & 63, wave = __builtin_amdgcn_readfirstlane(tid >> 6);
    const int G = gridDim.x;
    const int lo = args.ph_lo, hi = args.ph_hi;
    if (lo < 0) grid.sync();
    volatile LAS unsigned* misc = (volatile LAS unsigned*)(lds + 131072 + 256);
    if (tid == 0) { misc[0] = 0u; misc[1] = 0u; }
    __syncthreads();
    XcdBarrier bar = xcd_barrier_post((unsigned*)(kargs()->ws + WS_BAR), misc);
#ifndef PHASE_MASK
#define PHASE_MASK 0x1fff
#endif
#define IN(k) (((PHASE_MASK >> (k)) & 1) && lo <= (k) && (k) < hi)
#define SEAM(k) do { if (IN(k) && IN((k) + 1)) xcd_barrier(bar); } while (0)
#define PH_VARS const KArgs ka = kargs(); unsigned char* ws = ka->ws; float* ada = (float*)(ws + WS_ADA); bf16_t* XN = (bf16_t*)(ws + WS_XN); bf16_t* ACT = (bf16_t*)(ws + WS_ACT); const float* x = ka->in[0]; float* out = ka->out; (void)ada; (void)XN; (void)ACT; (void)x; (void)out;

    if (IN(0)) { prologue_phase(lds, wave, lane); }
    SEAM(0);
    if (IN(1)) { PH_VARS norm_phase((LAS float*)lds, x, XN, ka->in[4], ada, 0, (const float*)(ws + WS_PART), ka->in[3], tid, wave, lane); }
    SEAM(1);
    if (IN(2)) { PH_VARS pg8::Gemm g{XN, (const bf16_t*)(ws + WS_W1IN), M, 2 * FF, D, D, D, 0, 0}; pg8::StaticOrder S; S.init(M, 2 * FF, G, (int)blockIdx.x);
        pg8::EpiSwiGLU E{ACT}; pg8::gemm_phase(lds, g, S, E); convert_in_tail(lds, wave, lane, S.nwg, CV_B_LO, CV_B_HI); }
    SEAM(2);
    if (IN(3)) { PH_VARS pg8::Gemm g{ACT, (const bf16_t*)(ws + WS_W1OUT), M, D, FF, FF, FF, 0, 0}; pg8::StaticOrder S; S.init(M, D, G, (int)blockIdx.x);
        pg8::EpiResid E{x, out, ada + 0 * 6144 + 2 * D, 0.5f}; pg8::gemm_phase(lds, g, S, E); }
    SEAM(3);
    if (IN(4)) { PH_VARS norm_phase((LAS float*)lds, out, XN, ka->in[7], ada, 1, nullptr, nullptr, tid, wave, lane); }
    SEAM(4);
    if (IN(5)) { PH_VARS pg8::Gemm g{XN, (const bf16_t*)(ws + WS_WIN), M, NIN, D, D, D, 0, 0}; pg8::StaticOrder S; S.init(M, NIN, G, (int)blockIdx.x);
        pg8::EpiMixIn E{(bf16_t*)(ws + WS_GLU), (bf16_t*)(ws + WS_POOLIN), (bf16_t*)(ws + WS_GATEA), (bf16_t*)(ws + WS_GATEB)}; pg8::gemm_phase(lds, g, S, E); convert_in_tail(lds, wave, lane, S.nwg, CV_C_LO, CV_C_HI); }
    SEAM(5);
    if (IN(6)) { PH_VARS convpool_phase((LAS float*)lds, (const bf16_t*)(ws + WS_GLU), (const bf16_t*)(ws + WS_POOLIN), ka->in[9], ka->in[10], ka->in[11], ka->in[12], (bf16_t*)(ws + WS_AACT), (bf16_t*)(ws + WS_MIXED), tid, wave, lane); }
    SEAM(6);
    if (IN(7)) { PH_VARS
        pg8::StaticOrder S; S.init(M, D, G, (int)blockIdx.x);
        { pg8::Gemm g{(const bf16_t*)(ws + WS_MIXED), (const bf16_t*)(ws + WS_WB), M, D, 256, WP, 256, 1, 512};
          pg8::EpiMixOut<true> E{(const bf16_t*)(ws + WS_GATEB), ka->in[16], ka->in[17], nullptr, (bf16_t*)(ws + WS_TMP)}; pg8::gemm_phase(lds, g, S, E); }
        { pg8::Gemm g{(const bf16_t*)(ws + WS_AACT), (const bf16_t*)(ws + WS_WAOUT), M, D, WC, WC, WC, 0, 0};
          pg8::EpiMixOut<false> E{(const bf16_t*)(ws + WS_GATEA), ka->in[14], nullptr, (const bf16_t*)(ws + WS_TMP), (bf16_t*)(ws + WS_MIXM)}; pg8::gemm_phase(lds, g, S, E); }
    }
    SEAM(7);
    if (IN(8)) { PH_VARS pg8::Gemm g{(const bf16_t*)(ws + WS_MIXM), (const bf16_t*)(ws + WS_WOUT), M, D, D, D, D, 0, 0}; pg8::StaticOrder S; S.init(M, D, G, (int)blockIdx.x);
        pg8::EpiResid E{out, out, ada + 1 * 6144 + 2 * D, 1.0f}; pg8::gemm_phase(lds, g, S, E); }
    SEAM(8);
    if (IN(9)) { PH_VARS norm_phase((LAS float*)lds, out, XN, ka->in[19], ada, 2, nullptr, nullptr, tid, wave, lane); }
    SEAM(9);
    if (IN(10)) { PH_VARS pg8::Gemm g{XN, (const bf16_t*)(ws + WS_W2IN), M, 2 * FF, D, D, D, 0, 0}; pg8::StaticOrder S; S.init(M, 2 * FF, G, (int)blockIdx.x);
        pg8::EpiSwiGLU E{ACT}; pg8::gemm_phase(lds, g, S, E); }
    SEAM(10);
    if (IN(11)) { PH_VARS pg8::Gemm g{ACT, (const bf16_t*)(ws + WS_W2OUT), M, D, FF, FF, FF, 0, 0}; pg8::StaticOrder S; S.init(M, D, G, (int)blockIdx.x);
        pg8::EpiResid E{out, out, ada + 2 * 6144 + 2 * D, 0.5f}; pg8::gemm_phase(lds, g, S, E); }
    SEAM(11);
    if (IN(12)) { PH_VARS final_norm_phase(out, ka->in[22], wave, lane); }
#undef IN
#undef SEAM
}

extern "C" void kernel_launch(void* const* d_in, const int* in_sizes, int n_in, void* d_out, int out_size, void* d_ws, size_t ws_size, hipStream_t stream) {
    static int grid = 0;
    if (grid == 0) {
        if (n_in != 23 || in_sizes[0] != M * D || out_size != M * D || ws_size < WS_END) { fprintf(stderr, "kernel_launch: unexpected shapes (n_in %d, in0 %d, out %d, ws %zu); nothing launched\n", n_in, n_in > 0 ? in_sizes[0] : -1, out_size, ws_size); grid = -1; return; }
        int dev = 0, cus = 0, per_cu = 0;
        if (hipGetDevice(&dev) != hipSuccess || hipDeviceGetAttribute(&cus, hipDeviceAttributeMultiprocessorCount, dev) != hipSuccess) { fprintf(stderr, "kernel_launch: device query failed\n"); grid = -1; return; }
        if (hipFuncSetAttribute((const void*)fwd_megakernel, hipFuncAttributeMaxDynamicSharedMemorySize, LDS_BYTES) != hipSuccess) { fprintf(stderr, "kernel_launch: hipFuncSetAttribute failed\n"); grid = -1; return; }
        if (hipOccupancyMaxActiveBlocksPerMultiprocessor(&per_cu, (const void*)fwd_megakernel, 512, LDS_BYTES) != hipSuccess || per_cu < 1) { fprintf(stderr, "kernel_launch: occupancy query gives %d blocks per CU\n", per_cu); per_cu = 1; }
        (void)hipGetLastError();
        grid = cus * 1;
        fprintf(stderr, "kernel_launch: grid %d (cus %d, per_cu %d)\n", grid, cus, per_cu);
    }
    if (grid < 0) return;
    if (hipMemsetAsync((char*)d_ws + WS_BAR, 0, BAR_BYTES, stream) != hipSuccess) { fprintf(stderr, "kernel_launch: hipMemsetAsync failed\n"); return; }
    Args a{};
    for (int i = 0; i < 23; ++i) a.in[i] = (const float*)d_in[i];
    a.out = (float*)d_out; a.ws = (unsigned char*)d_ws;
#if MK_N_LAUNCHES == 1
    a.ph_lo = 0; a.ph_hi = NPH;
    void* kargs[] = {&a};
    hipError_t e = hipLaunchCooperativeKernel((const void*)fwd_megakernel, dim3(grid), dim3(512), kargs, LDS_BYTES, stream);
    if (e != hipSuccess) fprintf(stderr, "kernel_launch: cooperative launch failed: %s (grid %d)\n", hipGetErrorString(e), grid);
#else
    for (int p = 0; p < NPH; ++p) {
        a.ph_lo = p; a.ph_hi = p + 1;
        hipLaunchKernelGGL(fwd_megakernel, dim3(grid), dim3(512), LDS_BYTES, stream, a);
    }
#endif
}
```
